# Optimizing an MI355X kernel written in HIP

```python
import jax, jax.numpy as jnp
from jax import lax
import numpy as np

D_MODEL = 1024
BATCH = 4
SEQ = 8192
DEPTH = 2

N_MIXERS = 2
MLSTM_HEADS = 4
MLSTM_DK = 128
MLSTM_DV = D_MODEL // MLSTM_HEADS
MLSTM_CHUNK = 128
QK_WIDTH = MLSTM_HEADS * MLSTM_DK
V_WIDTH = MLSTM_HEADS * MLSTM_DV
N_GATE_COLS = 4 * MLSTM_HEADS
MLSTM_IN_WIDTH = 2 * QK_WIDTH + 2 * V_WIDTH + N_GATE_COLS
FORGET_BIAS = 3.0
POOL_WINDOWS = (2, 4, 8, 16)
POOL_GROUPS = len(POOL_WINDOWS)
POOL_GROUP_WIDTH = D_MODEL // POOL_GROUPS
D_FF = 4 * D_MODEL
PLE_DIM = 256
N_MLSTM_LAYERS = (DEPTH + N_MIXERS - 1) // N_MIXERS
N_POOL_LAYERS = DEPTH // N_MIXERS
EPS = 1e-6

kernel_name = 'hybrid_mlstm_pool_encoder'


def rmsnorm(x, gain):
    x32 = x.astype(jnp.float32)
    y = x32 * lax.rsqrt(jnp.mean(jnp.square(x32), axis=-1, keepdims=True) + EPS)
    return (y * gain.astype(jnp.float32)).astype(x.dtype)


def mlstm_scan(q, k, v, i_pre, f_pre):
    B, H, S, DK = q.shape
    DV = v.shape[-1]
    L = MLSTM_CHUNK
    NC = S // L

    def chunks(t):
        return jnp.moveaxis(t.reshape((B, H, NC, L) + t.shape[3:]), 2, 0)

    qc, kc, vc = chunks(q), chunks(k), chunks(v)
    ic = chunks(i_pre)
    bc = jnp.cumsum(chunks(jax.nn.log_sigmoid(f_pre)), axis=-1)
    lower = jnp.tril(jnp.ones((L, L), dtype=bool))

    def step(carry, xs):
        C, n, m = carry
        q_, k_, v_, i_, b_ = xs
        b_last = b_[..., -1]
        log_d = jnp.where(lower, b_[..., :, None] - b_[..., None, :] + i_[..., None, :], -jnp.inf)
        log_inter = b_ + m[..., None]
        m_t = jnp.maximum(log_inter, jnp.max(log_d, axis=-1))
        d = jnp.exp(log_d - m_t[..., None])
        inter = jnp.exp(log_inter - m_t)
        s = jnp.einsum('bhtd,bhsd->bhts', q_, k_) * d
        num = jnp.einsum('bhts,bhsv->bhtv', s, v_) + inter[..., None] * jnp.einsum('bhtd,bhvd->bhtv', q_, C)
        den = jnp.sum(s, axis=-1) + inter * jnp.einsum('bhtd,bhd->bht', q_, n)
        h = num / jnp.maximum(jnp.abs(den), jnp.exp(-m_t))[..., None]
        log_w = b_last[..., None] - b_ + i_
        m_new = jnp.maximum(b_last + m, jnp.max(log_w, axis=-1))
        w = jnp.exp(log_w - m_new[..., None])
        decay = jnp.exp(b_last + m - m_new)
        C = decay[..., None, None] * C + jnp.einsum('bhsv,bhsd->bhvd', w[..., None] * v_, k_)
        n = decay[..., None] * n + jnp.einsum('bhs,bhsd->bhd', w, k_)
        return (C, n, m_new), h

    init = (jnp.zeros((B, H, DV, DK), jnp.float32),
            jnp.zeros((B, H, DK), jnp.float32),
            jnp.zeros((B, H), jnp.float32))
    _, hs = lax.scan(step, init, (qc, kc, vc, ic, bc))
    return jnp.moveaxis(hs, 0, 2).reshape(B, H, S, DV)


def mlstm_mixer(xn, w_in, b_gates, head_norm, w_out):
    B, S, _ = xn.shape
    u = xn @ w_in
    q, k, v, o, g = jnp.split(u, [QK_WIDTH, 2 * QK_WIDTH, 2 * QK_WIDTH + V_WIDTH,
                                  2 * QK_WIDTH + 2 * V_WIDTH], axis=-1)
    q = q.reshape(B, S, MLSTM_HEADS, MLSTM_DK).transpose(0, 2, 1, 3).astype(jnp.float32)
    k = (k.reshape(B, S, MLSTM_HEADS, MLSTM_DK).transpose(0, 2, 1, 3).astype(jnp.float32)
         * (MLSTM_DK ** -0.5))
    v = v.reshape(B, S, MLSTM_HEADS, MLSTM_DV).transpose(0, 2, 1, 3).astype(jnp.float32)
    g = g.reshape(B, S, 4, MLSTM_HEADS).astype(jnp.float32) + b_gates.astype(jnp.float32)
    g = g.transpose(2, 0, 3, 1)
    h_fwd = mlstm_scan(q, k, v, g[0], g[1])
    flip = lambda t: jnp.flip(t, axis=2)
    h_bwd = flip(mlstm_scan(flip(q), flip(k), flip(v), flip(g[2]), flip(g[3])))
    h = (h_fwd + h_bwd).transpose(0, 2, 1, 3)
    h = h * lax.rsqrt(jnp.mean(jnp.square(h), axis=-1, keepdims=True) + EPS)
    h = h * head_norm.astype(jnp.float32).reshape(MLSTM_HEADS, MLSTM_DV)
    h = h.reshape(B, S, V_WIDTH) * jax.nn.sigmoid(o.astype(jnp.float32))
    return h.astype(xn.dtype) @ w_out


def pool_mixer(xn, w_in, w_grp, scale, w_out):
    B, S, D = xn.shape
    u = (xn @ w_in).astype(jnp.float32)
    cs = jnp.concatenate([jnp.zeros((B, 1, D), jnp.float32), jnp.cumsum(u, axis=1)], axis=1)
    t = jnp.arange(S)
    pooled = []
    for gi, win in enumerate(POOL_WINDOWS):
        c0, c1 = gi * POOL_GROUP_WIDTH, (gi + 1) * POOL_GROUP_WIDTH
        lo = jnp.clip(t - win // 2, 0, S)
        hi = jnp.clip(t + win - win // 2, 0, S)
        csg = cs[:, :, c0:c1]
        mean = (csg[:, hi] - csg[:, lo]) / (hi - lo).astype(jnp.float32)[None, :, None]
        pooled.append(mean)
    y = jnp.concatenate(pooled, axis=-1) - u
    y = jnp.einsum('bsgc,gcd->bsgd', y.reshape(B, S, POOL_GROUPS, POOL_GROUP_WIDTH),
                   w_grp.astype(jnp.float32)).reshape(B, S, D)
    y = y * scale.astype(jnp.float32)
    return y.astype(xn.dtype) @ w_out


def sqrelu_mlp(xn, w1, w2):
    return jnp.square(jax.nn.relu(xn @ w1)) @ w2


def setup_inputs(seed: int = 0) -> dict:
    key = jax.random.key(seed)
    ks = jax.random.split(key, 24)

    def nrm(k, shape, fan_in):
        return jax.random.normal(k, shape, jnp.float32) * (fan_in ** -0.5)

    def gain(k, shape):
        return 1.0 + 0.05 * jax.random.normal(k, shape, jnp.float32)

    nA, nB = N_MLSTM_LAYERS, N_POOL_LAYERS
    gate_base = jnp.array([0.0, FORGET_BIAS, 0.0, FORGET_BIAS], jnp.float32)[None, :, None]
    return {
        'x': jax.random.normal(ks[0], (BATCH, SEQ, D_MODEL), jnp.float32),
        'p': jax.random.normal(ks[1], (DEPTH, BATCH, SEQ, PLE_DIM), jnp.float32),
        'norm_mix': gain(ks[2], (DEPTH, D_MODEL)),
        'norm_mlp': gain(ks[3], (DEPTH, D_MODEL)),
        'norm_ple': gain(ks[4], (DEPTH, D_MODEL)),
        'norm_final': gain(ks[5], (D_MODEL,)),
        'mlstm_w_in': nrm(ks[6], (nA, D_MODEL, MLSTM_IN_WIDTH), D_MODEL),
        'mlstm_b_gates': gate_base + 0.1 * jax.random.normal(ks[7], (nA, 4, MLSTM_HEADS), jnp.float32),
        'mlstm_head_norm': gain(ks[8], (nA, V_WIDTH)),
        'mlstm_w_out': nrm(ks[9], (nA, V_WIDTH, D_MODEL), V_WIDTH),
        'pool_w_in': nrm(ks[10], (nB, D_MODEL, D_MODEL), D_MODEL),
        'pool_w_grp': nrm(ks[11], (nB, POOL_GROUPS, POOL_GROUP_WIDTH, POOL_GROUP_WIDTH), POOL_GROUP_WIDTH),
        'pool_scale': gain(ks[12], (nB, D_MODEL)),
        'pool_w_out': nrm(ks[13], (nB, D_MODEL, D_MODEL), D_MODEL),
        'mlp_w1': nrm(ks[14], (DEPTH, D_MODEL, D_FF), D_MODEL),
        'mlp_w2': nrm(ks[15], (DEPTH, D_FF, D_MODEL), D_FF),
        'ple_w': nrm(ks[16], (DEPTH, PLE_DIM, D_MODEL), PLE_DIM),
        'ple_gate_w': nrm(ks[17], (DEPTH, D_MODEL, D_MODEL), D_MODEL),
        'ple_gate_b': 0.02 * jax.random.normal(ks[18], (DEPTH, D_MODEL), jnp.float32),
    }


def reference(x, p, norm_mix, norm_mlp, norm_ple, norm_final,
              mlstm_w_in, mlstm_b_gates, mlstm_head_norm, mlstm_w_out,
              pool_w_in, pool_w_grp, pool_scale, pool_w_out,
              mlp_w1, mlp_w2, ple_w, ple_gate_w, ple_gate_b):
    h = x
    for i in range(DEPTH):
        xn = rmsnorm(h, norm_mix[i])
        j = i // N_MIXERS
        if i % N_MIXERS == 0:
            mix = mlstm_mixer(xn, mlstm_w_in[j], mlstm_b_gates[j], mlstm_head_norm[j], mlstm_w_out[j])
        else:
            mix = pool_mixer(xn, pool_w_in[j], pool_w_grp[j], pool_scale[j], pool_w_out[j])
        h = h + mix
        h = h + sqrelu_mlp(rmsnorm(h, norm_mlp[i]), mlp_w1[i], mlp_w2[i])
        gate = jax.nn.sigmoid((rmsnorm(h, norm_ple[i]) @ ple_gate_w[i] + ple_gate_b[i]).astype(jnp.float32))
        h = h + (gate * (p[i] @ ple_w[i]).astype(jnp.float32)).astype(h.dtype)
    return rmsnorm(h, norm_final)
```

```cpp
#include <hip/hip_runtime.h>
#include <hip/hip_cooperative_groups.h>
#include <cstdio>
#include <cstdint>
namespace cg = cooperative_groups;

#ifndef MK_MULTI
#define MK_MULTI 0
#endif

#define LAS __attribute__((address_space(3)))
typedef unsigned short bf16_t;
typedef short bf16x8 __attribute__((ext_vector_type(8)));
typedef float f32x4 __attribute__((ext_vector_type(4)));
typedef float f32x2 __attribute__((ext_vector_type(2)));
typedef unsigned u32x4 __attribute__((ext_vector_type(4)));
typedef unsigned u32x2 __attribute__((ext_vector_type(2)));

constexpr int DM = 1024, NB = 4, SEQ = 8192, M = NB * SEQ, FF = 4096, PLE = 256;
constexpr int NH = 4, DK = 128, DV = 256, LCH = 128, NCH = SEQ / LCH;
constexpr int WIN_N = 3088;
constexpr int NA = 1792, NBK = 1536;
constexpr float EPS = 1e-6f;

constexpr size_t MiB = 1u << 20;
constexpr size_t WS_GATES = 1 * MiB;
constexpr size_t WS_SS = 3 * MiB;
constexpr size_t WS_NST = 4 * MiB;
constexpr size_t WS_TOKV = 5 * MiB;
constexpr size_t WS_W = 10 * MiB;
constexpr size_t WS_XB = 64 * MiB;
constexpr size_t WS_PB = 128 * MiB;
constexpr size_t WS_HM = 160 * MiB;
constexpr size_t WS_U = 224 * MiB;
constexpr size_t WS_QB = WS_U, WS_KB = WS_U + 32 * MiB, WS_KT = WS_U + 64 * MiB, WS_VT = WS_U + 96 * MiB, WS_SO = WS_U + 160 * MiB;
constexpr size_t WS_ACT = 224 * MiB;
constexpr size_t WS_U1 = 224 * MiB;
constexpr size_t WS_Y0 = 352 * MiB;
constexpr size_t WS_Y1 = 416 * MiB;
constexpr size_t WS_END = 480 * MiB;
constexpr size_t WO_WIN = 0;
constexpr size_t WO_WOUT = WO_WIN + (size_t)3328 * 1024;
constexpr size_t WO_PIN = WO_WOUT + (size_t)1024 * 1024;
constexpr size_t WO_GRP = WO_PIN + (size_t)1024 * 1024;
constexpr size_t WO_POUT = WO_GRP + (size_t)1024 * 256;
constexpr size_t WO_W1 = WO_POUT + (size_t)1024 * 1024;
constexpr size_t WO_W2 = WO_W1 + (size_t)2 * 4096 * 1024;
constexpr size_t WO_PLE = WO_W2 + (size_t)2 * 4096 * 1024;
constexpr size_t WO_GATE = WO_PLE + (size_t)2 * 1024 * 256;
constexpr size_t WO_END = WO_GATE + (size_t)2 * 1024 * 1024;
static_assert(WS_W + WO_END * 2 <= WS_XB, "weights fit");

constexpr int LDS_BYTES = 147456;

__device__ __forceinline__ unsigned cvt_pk_bf16(float lo, float hi) { unsigned r; asm volatile("v_cvt_pk_bf16_f32 %0, %1, %2" : "=v"(r) : "v"(lo), "v"(hi)); return r; }
__device__ __forceinline__ float bf_lo(unsigned w) { return __uint_as_float(w << 16); }
__device__ __forceinline__ float bf_hi(unsigned w) { return __uint_as_float(w & 0xffff0000u); }
__device__ __forceinline__ float sigmoidf_(float v) { return 1.0f / (1.0f + __expf(-v)); }

__device__ __forceinline__ float shx(float v, int mask, int lane) { return __int_as_float(__builtin_amdgcn_ds_bpermute((lane ^ mask) << 2, __float_as_int(v))); }
__device__ __forceinline__ float shup(float v, int d, int lane) { return __int_as_float(__builtin_amdgcn_ds_bpermute((lane - d) << 2, __float_as_int(v))); }
__device__ __forceinline__ int lane_id_fresh() { unsigned m = ~0u; asm volatile("" : "+s"(m)); return (int)__builtin_amdgcn_mbcnt_hi(m, __builtin_amdgcn_mbcnt_lo(m, 0u)); }
namespace pg8 {
constexpr int BM = 256, BK = 64, HALF = 128, HTB = HALF * BK * 2, STAGE_BYTES = 8 * HTB, NXCD = 8, WGM = 8;
__host__ __device__ __forceinline__ int lds_byte(int r, int c) { const int st = (r >> 4) * 2 + (c >> 5), rr = r & 15, cc = c & 31, ob = rr * 64 + cc * 2; return st * 1024 + (ob ^ (((ob >> 9) & 1) << 5)); }
__host__ __device__ __forceinline__ void stage_rc(int b, int& R, int& C) { const int st = b / 1024, sb = b % 1024, swz = sb ^ (((sb >> 9) & 1) << 5); R = (st >> 1) * 16 + swz / 64; C = (st & 1) * 32 + (swz % 64) / 2; }
__host__ __device__ __forceinline__ int perm32(int rho) { const int n = rho >> 4, i = rho & 15; return 8 * (i >> 2) + 4 * n + (i & 3); }

struct Unit { int pm, pn; };
struct Gemm { const bf16_t* A; const bf16_t* Bt; int M, N, K; size_t acol; };

struct StaticOrder {
    int nM, nN, nwg, G, c;
    __device__ void init(int M_, int N_, int G_, int c_) { nM = M_ / BM; nN = N_ / BM; nwg = nM * nN; G = G_; c = c_; }
    __device__ bool next(int i, Unit& u) const {
        const long L = (long)i * G + c; if (L >= nwg) return false;
        int wgid = (int)L; { const int q = nwg / NXCD, r = nwg % NXCD, xcd = wgid % NXCD, off = wgid / NXCD; wgid = (xcd < r ? xcd * (q + 1) : r * (q + 1) + (xcd - r) * q) + off; }
        const int nig = WGM * nN, gid = wgid / nig, fm = gid * WGM, gsz = (nM - fm) < WGM ? (nM - fm) : WGM;
        u.pm = fm + ((wgid % nig) % gsz); u.pn = (wgid % nig) / gsz; return true;
    }
};

template <class Epi>
__device__ __forceinline__ void gemm_phase(LAS unsigned char* lds, const Gemm g, const StaticOrder& S, const Epi& E, int tid_in) {
    int tid_ = tid_in; asm volatile("" : "+v"(tid_));
    const int tid = tid_, wid = __builtin_amdgcn_readfirstlane(tid >> 6), lane = tid & 63, wr = wid >> 2, wc = wid & 3, fr = lane & 15, fq = lane >> 4;
    const int K = g.K, nt = K / BK;
    unsigned voffA[2], voffB[2];
#pragma unroll
    for (int i = 0; i < 2; ++i) { int R, C; stage_rc(tid * 16 + i * 8192, R, C); const int Rb = Epi::PERM ? ((R & ~31) + perm32(R & 31)) : R;
        voffA[i] = (unsigned)(R * K + C) * 2u; voffB[i] = (unsigned)(Rb * K + C) * 2u; }
    const size_t kstep = (size_t)(BK * 2);
    const size_t hstep = (size_t)HALF * K * 2;
    const size_t tstep = 2 * hstep;
    const unsigned ldsw = (unsigned)wid * 1024u;
    const int aoff = lds_byte(wr * 64 + fr, fq * 8), boff = lds_byte(wc * 32 + fr, fq * 8);
#define PG8_SA(b, h) (((b) * 2 + (h)) * HTB)
#define PG8_SB(b, h) ((4 + (b) * 2 + (h)) * HTB)
#define PG8_STAGE(bufoff, gbase, voff) do { const char* gb_ = (const char*)(gbase); asm volatile("" : "+s"(gb_));   \
        _Pragma("unroll") for (int _i = 0; _i < 2; ++_i) \
        __builtin_amdgcn_global_load_lds((const unsigned*)(gb_ + (voff)[_i]), (LAS unsigned*)(lds + (bufoff) + ldsw + _i * 8192), 16, 0, 0); } while (0)
#define PG8_LDA(dst, b, h) do { _Pragma("unroll") for (int m = 0; m < 4; ++m) _Pragma("unroll") for (int k = 0; k < 2; ++k) dst[m][k] = *(const LAS bf16x8*)(lds + PG8_SA(b, h) + aoff + m * 2048 + k * 1024); } while (0)
#define PG8_LDB(dst, b, h) do { _Pragma("unroll") for (int n = 0; n < 2; ++n) _Pragma("unroll") for (int k = 0; k < 2; ++k) dst[n][k] = *(const LAS bf16x8*)(lds + PG8_SB(b, h) + boff + n * 2048 + k * 1024); } while (0)
#define PG8_MMA(ai, bj, At, Bt) do { __builtin_amdgcn_s_setprio(1); _Pragma("unroll") for (int m = 0; m < 4; ++m) _Pragma("unroll") for (int n = 0; n < 2; ++n) _Pragma("unroll") for (int k = 0; k < 2; ++k) \
        acc[ai][bj][m][n] = Epi::SWAP ? __builtin_amdgcn_mfma_f32_16x16x32_bf16(At[m][k], Bt[n][k], acc[ai][bj][m][n], 0, 0, 0) \
                                      : __builtin_amdgcn_mfma_f32_16x16x32_bf16(Bt[n][k], At[m][k], acc[ai][bj][m][n], 0, 0, 0); __builtin_amdgcn_s_setprio(0); } while (0)
#define PG8_WAIT_V(n) asm volatile("s_waitcnt vmcnt(" #n ")" ::: "memory")
#define PG8_WAIT_L(n) asm volatile("s_waitcnt lgkmcnt(" #n ")" ::: "memory")
#define PG8_BAR __builtin_amdgcn_s_barrier()
#define PG8_SCHED __builtin_amdgcn_sched_barrier(0)
    Unit cur, nxt; int ui = 0;
    if (!S.next(0, cur)) return;
    f32x4 acc[2][2][4][2];
#pragma unroll
    for (int a = 0; a < 2; ++a)
#pragma unroll
        for (int b = 0; b < 2; ++b)
#pragma unroll
            for (int m = 0; m < 4; ++m)
#pragma unroll
                for (int n = 0; n < 2; ++n) acc[a][b][m][n] = (f32x4){0.f, 0.f, 0.f, 0.f};
    bf16x8 At[4][2], B0[2][2], B1[2][2];
    const char* cA = (const char*)g.A + (size_t)cur.pm * tstep + (size_t)cur.pn * g.acol * 2; const char* cB = (const char*)g.Bt + (size_t)cur.pn * tstep;
    PG8_STAGE(PG8_SB(0, 0), cB, voffB); PG8_STAGE(PG8_SB(0, 1), cB + hstep, voffB); PG8_STAGE(PG8_SA(0, 0), cA, voffA); PG8_STAGE(PG8_SA(0, 1), cA + hstep, voffA);
    if (wr == 1) PG8_BAR;
    PG8_WAIT_V(2); PG8_BAR;
    PG8_STAGE(PG8_SB(1, 0), cB + kstep, voffB); PG8_STAGE(PG8_SA(1, 0), cA + kstep, voffA); PG8_STAGE(PG8_SB(1, 1), cB + hstep + kstep, voffB);
    PG8_WAIT_V(6); PG8_BAR;
    for (;;) {
        const bool has_next = S.next(ui + 1, nxt);
        const char* nA = has_next ? (const char*)g.A + (size_t)nxt.pm * tstep + (size_t)nxt.pn * g.acol * 2 : cA; const char* nB = has_next ? (const char*)g.Bt + (size_t)nxt.pn * tstep : cB;
        for (int t = 0; t < nt; t += 2) {
            const bool last = (t == nt - 2);
            const char* a1 = cA + (size_t)(t + 1) * kstep;
            const char* a2 = last ? nA : cA + (size_t)(t + 2) * kstep; const char* b2 = last ? nB : cB + (size_t)(t + 2) * kstep;
            const char* a3 = a2 + kstep; const char* b3 = b2 + kstep;
            PG8_LDB(B0, 0, 0); PG8_LDB(B1, 0, 1); PG8_SCHED; PG8_LDA(At, 0, 0); PG8_STAGE(PG8_SA(1, 1), a1 + hstep, voffA);
            PG8_WAIT_V(8); PG8_WAIT_L(0); PG8_BAR; PG8_MMA(0, 0, At, B0); PG8_MMA(0, 1, At, B1); PG8_BAR; PG8_SCHED;
            PG8_LDA(At, 0, 1); PG8_STAGE(PG8_SB(0, 0), b2, voffB); PG8_STAGE(PG8_SB(0, 1), b2 + hstep, voffB); PG8_STAGE(PG8_SA(0, 0), a2, voffA);
            PG8_WAIT_V(8); PG8_WAIT_L(0); PG8_BAR; PG8_MMA(1, 0, At, B0); PG8_MMA(1, 1, At, B1); PG8_BAR; PG8_SCHED;
            PG8_LDB(B0, 1, 0); PG8_LDB(B1, 1, 1); PG8_SCHED; PG8_LDA(At, 1, 0); PG8_STAGE(PG8_SA(0, 1), a2 + hstep, voffA);
            PG8_WAIT_V(8); PG8_WAIT_L(0); PG8_BAR; PG8_MMA(0, 0, At, B0); PG8_MMA(0, 1, At, B1); PG8_BAR; PG8_SCHED;
            PG8_LDA(At, 1, 1); PG8_STAGE(PG8_SB(1, 0), b3, voffB); PG8_STAGE(PG8_SB(1, 1), b3 + hstep, voffB); PG8_STAGE(PG8_SA(1, 0), a3, voffA);
            PG8_WAIT_V(8); PG8_WAIT_L(0); PG8_BAR; PG8_MMA(1, 0, At, B0); PG8_MMA(1, 1, At, B1); PG8_BAR; PG8_SCHED;
        }
        if (wr == 0) PG8_BAR;
        const int lane2 = lane_id_fresh();
        E(acc, cur, wr, wc, lane2 & 15, lane2 >> 4);
        if (!has_next) break;
        { int t2 = wid * 64 + lane_id_fresh();
#pragma unroll
          for (int i = 0; i < 2; ++i) { int R, C; stage_rc(t2 * 16 + i * 8192, R, C); const int Rb = Epi::PERM ? ((R & ~31) + perm32(R & 31)) : R;
              voffA[i] = (unsigned)(R * K + C) * 2u; voffB[i] = (unsigned)(Rb * K + C) * 2u; } }
#pragma unroll
        for (int a = 0; a < 2; ++a)
#pragma unroll
            for (int b = 0; b < 2; ++b)
#pragma unroll
                for (int m = 0; m < 4; ++m)
#pragma unroll
                    for (int n = 0; n < 2; ++n) acc[a][b][m][n] = (f32x4){0.f, 0.f, 0.f, 0.f};
        cur = nxt; cA = nA; cB = nB; ++ui;
        if (wr == 1) PG8_BAR;
    }
    PG8_WAIT_V(0);
    PG8_BAR;
#undef PG8_SA
#undef PG8_SB
#undef PG8_STAGE
#undef PG8_LDA
#undef PG8_LDB
#undef PG8_MMA
#undef PG8_WAIT_V
#undef PG8_WAIT_L
#undef PG8_BAR
#undef PG8_SCHED
}
}

enum { EP_QO = 0, EP_KV, EP_RES, EP_GATE, EP_SQRELU, EP_BF16, EP_F32SCALE, EP_RES32, EP_BF16S };
struct EpiArgs {
    const float* ss_in;
    const float* res32;
    const bf16_t* res16;
    bf16_t* xbo;
    float* ss_out;
    const float* bias;
    const bf16_t* pe;
    bf16_t* o16; int ldc;
    float* o32;
    bf16_t *qb, *kb, *kt, *vt, *so; float* gates;
};
template <int MODE> struct Epi {
    static constexpr bool PERM = (MODE != EP_KV), SWAP = (MODE == EP_KV);
    EpiArgs a;
    __device__ __forceinline__ void operator()(const f32x4 (&acc)[2][2][4][2], const pg8::Unit& u, int wr, int wc, int fr_, int fq_) const {
        int fr = fr_, fq = fq_; asm volatile("" : "+v"(fr), "+v"(fq));
        if constexpr (MODE == EP_KV) {
#pragma unroll
            for (int ai = 0; ai < 2; ++ai)
#pragma unroll
                for (int m = 0; m < 4; ++m) {
                    const int row0 = u.pm * 256 + ai * 128 + wr * 64 + m * 16 + 4 * fq;
                    const f32x4 s4 = *(const f32x4*)(a.ss_in + row0);
                    f32x4 r4; r4.x = rsqrtf(s4.x * (1.f / DM) + EPS); r4.y = rsqrtf(s4.y * (1.f / DM) + EPS); r4.z = rsqrtf(s4.z * (1.f / DM) + EPS); r4.w = rsqrtf(s4.w * (1.f / DM) + EPS);
                    const int b = row0 >> 13, tok = row0 & 8191;
#pragma unroll
                    for (int bj = 0; bj < 2; ++bj)
#pragma unroll
                        for (int n = 0; n < 2; ++n) {
                            const int col = u.pn * 256 + bj * 128 + wc * 32 + 16 * n + fr;
                            const f32x4 v = acc[ai][bj][m][n] * r4;
                            u32x2 w; w.x = cvt_pk_bf16(v.x, v.y); w.y = cvt_pk_bf16(v.z, v.w);
                            if (u.pn < 2) {
                                const int hd = col >> 7, dk = col & 127;
                                *(u32x2*)(a.kt + ((size_t)((b * NH + hd) * DK + dk)) * SEQ + tok) = w;
                                bf16_t* kr = a.kb + (size_t)row0 * 512 + col;
                                kr[0] = (bf16_t)(w.x & 0xffff); kr[512] = (bf16_t)(w.x >> 16); kr[1024] = (bf16_t)(w.y & 0xffff); kr[1536] = (bf16_t)(w.y >> 16);
                            } else {
                                const int vc = col - 512, hd = vc >> 8, dv = vc & 255;
                                *(u32x2*)(a.vt + ((size_t)((b * NH + hd) * DV + dv)) * SEQ + tok) = w;
                            }
                        }
                }
        } else {
            const int rowb = u.pm * 256 + wr * 64 + fr, colb = u.pn * 256 + wc * 32 + 8 * fq;
#pragma unroll
            for (int ai = 0; ai < 2; ++ai)
#pragma unroll
                for (int m = 0; m < 4; ++m) {
                    const int row = rowb + ai * 128 + m * 16;
                    float rs = 1.f;
                    if constexpr (MODE == EP_QO || MODE == EP_GATE || MODE == EP_SQRELU || MODE == EP_F32SCALE || MODE == EP_BF16S) rs = rsqrtf(a.ss_in[row] * (1.f / DM) + EPS);
                    float ssq = 0.f;
#pragma unroll
                    for (int bj = 0; bj < 2; ++bj) {
                        const int col = colb + bj * 128;
                        f32x4 v0 = acc[ai][bj][m][0] * rs, v1 = acc[ai][bj][m][1] * rs;
                        if constexpr (MODE == EP_QO) {
                            if (u.pn < 2) {
                                u32x4 w; w.x = cvt_pk_bf16(v0.x, v0.y); w.y = cvt_pk_bf16(v0.z, v0.w); w.z = cvt_pk_bf16(v1.x, v1.y); w.w = cvt_pk_bf16(v1.z, v1.w);
                                *(u32x4*)(a.qb + (size_t)row * 512 + col) = w;
                            } else if (u.pn < 6) {
                                u32x4 w; w.x = cvt_pk_bf16(sigmoidf_(v0.x), sigmoidf_(v0.y)); w.y = cvt_pk_bf16(sigmoidf_(v0.z), sigmoidf_(v0.w));
                                w.z = cvt_pk_bf16(sigmoidf_(v1.x), sigmoidf_(v1.y)); w.w = cvt_pk_bf16(sigmoidf_(v1.z), sigmoidf_(v1.w));
                                *(u32x4*)(a.so + (size_t)row * 1024 + (col - 512)) = w;
                            } else {
                                if (bj == 0 && wc == 0 && fq < 2) {
                                    const f32x4 b0 = *(const f32x4*)(a.bias + 8 * fq), b1 = *(const f32x4*)(a.bias + 8 * fq + 4);
                                    *(f32x4*)(a.gates + (size_t)row * 16 + 8 * fq) = v0 + b0; *(f32x4*)(a.gates + (size_t)row * 16 + 8 * fq + 4) = v1 + b1;
                                }
                            }
                        } else if constexpr (MODE == EP_SQRELU) {
                            v0.x = fmaxf(v0.x, 0.f); v0.y = fmaxf(v0.y, 0.f); v0.z = fmaxf(v0.z, 0.f); v0.w = fmaxf(v0.w, 0.f);
                            v1.x = fmaxf(v1.x, 0.f); v1.y = fmaxf(v1.y, 0.f); v1.z = fmaxf(v1.z, 0.f); v1.w = fmaxf(v1.w, 0.f);
                            v0 = v0 * v0; v1 = v1 * v1;
                            u32x4 w; w.x = cvt_pk_bf16(v0.x, v0.y); w.y = cvt_pk_bf16(v0.z, v0.w); w.z = cvt_pk_bf16(v1.x, v1.y); w.w = cvt_pk_bf16(v1.z, v1.w);
                            *(u32x4*)(a.o16 + (size_t)row * a.ldc + col) = w;
                        } else if constexpr (MODE == EP_BF16 || MODE == EP_BF16S) {
                            u32x4 w; w.x = cvt_pk_bf16(v0.x, v0.y); w.y = cvt_pk_bf16(v0.z, v0.w); w.z = cvt_pk_bf16(v1.x, v1.y); w.w = cvt_pk_bf16(v1.z, v1.w);
                            *(u32x4*)(a.o16 + (size_t)row * a.ldc + col) = w;
                        } else if constexpr (MODE == EP_F32SCALE) {
                            *(f32x4*)(a.o32 + (size_t)row * DM + col) = v0; *(f32x4*)(a.o32 + (size_t)row * DM + col + 4) = v1;
                        } else {
                            const size_t off = (size_t)row * DM + col;
                            f32x4 r0, r1;
                            if constexpr (MODE == EP_RES32) { r0 = *(const f32x4*)(a.res32 + off); r1 = *(const f32x4*)(a.res32 + off + 4); }
                            else { const u32x4 rw = *(const u32x4*)(a.res16 + off); r0 = (f32x4){bf_lo(rw.x), bf_hi(rw.x), bf_lo(rw.y), bf_hi(rw.y)}; r1 = (f32x4){bf_lo(rw.z), bf_hi(rw.z), bf_lo(rw.w), bf_hi(rw.w)}; }
                            if constexpr (MODE == EP_GATE) {
                                const f32x4 b0 = *(const f32x4*)(a.bias + col), b1 = *(const f32x4*)(a.bias + col + 4);
                                const u32x4 pw = *(const u32x4*)(a.pe + off);
                                v0 = v0 + b0; v1 = v1 + b1;
                                v0.x = sigmoidf_(v0.x) * bf_lo(pw.x); v0.y = sigmoidf_(v0.y) * bf_hi(pw.x); v0.z = sigmoidf_(v0.z) * bf_lo(pw.y); v0.w = sigmoidf_(v0.w) * bf_hi(pw.y);
                                v1.x = sigmoidf_(v1.x) * bf_lo(pw.z); v1.y = sigmoidf_(v1.y) * bf_hi(pw.z); v1.z = sigmoidf_(v1.z) * bf_lo(pw.w); v1.w = sigmoidf_(v1.w) * bf_hi(pw.w);
                            }
                            v0 = v0 + r0; v1 = v1 + r1;
                            u32x4 w; w.x = cvt_pk_bf16(v0.x, v0.y); w.y = cvt_pk_bf16(v0.z, v0.w); w.z = cvt_pk_bf16(v1.x, v1.y); w.w = cvt_pk_bf16(v1.z, v1.w);
                            *(u32x4*)(a.xbo + off) = w;
                            v0 = (f32x4){bf_lo(w.x), bf_hi(w.x), bf_lo(w.y), bf_hi(w.y)}; v1 = (f32x4){bf_lo(w.z), bf_hi(w.z), bf_lo(w.w), bf_hi(w.w)};
                            ssq += (v0.x * v0.x + v0.y * v0.y) + (v0.z * v0.z + v0.w * v0.w) + (v1.x * v1.x + v1.y * v1.y) + (v1.z * v1.z + v1.w * v1.w);
                        }
                    }
                    if constexpr (MODE == EP_RES || MODE == EP_RES32 || MODE == EP_GATE) {
                        const int ln_ = fq * 16 + fr; ssq += shx(ssq, 16, ln_); ssq += shx(ssq, 32, ln_);
                        if (fq == 0) atomicAdd(a.ss_out + row, ssq);
                    }
                    asm volatile("" ::: "memory");
                }
        }
    }
};

struct Args { const float* in[19]; float* out; unsigned char* ws; int ph_lo, ph_hi; };
struct Frame {
    LAS unsigned char* lds; int tid, lane, wave, G, bid;
    unsigned char* ws; float* out;
};

__device__ __forceinline__ float wave_sum(float v, int lane) {
#pragma unroll
    for (int o = 1; o < 64; o <<= 1) v += shx(v, o, lane);
    return v;
}

__device__ __forceinline__ void transpose_item(const float* W, int N, int k0, int n0, bf16_t* WT, int ldt, int drow0, const float* kgain, const float* ngain, float scale, LAS float* scr, int lane) {
    const int nn = n0 + (lane & 31);
    float v[32];
#pragma unroll
    for (int i = 0; i < 32; ++i) v[i] = (nn < N) ? W[(size_t)(k0 + 2 * i + (lane >> 5)) * N + nn] : 0.f;
#pragma unroll
    for (int i = 0; i < 32; ++i) scr[(2 * i + (lane >> 5)) * 33 + (lane & 31)] = v[i];
    asm volatile("s_waitcnt lgkmcnt(0)" ::: "memory");
    const int c = lane & 7;
    f32x4 g0 = {1.f, 1.f, 1.f, 1.f}, g1 = g0;
    if (kgain) { g0 = *(const f32x4*)(kgain + k0 + 8 * c); g1 = *(const f32x4*)(kgain + k0 + 8 * c + 4); }
#pragma unroll
    for (int j = 0; j < 4; ++j) { const int n = (lane >> 3) + 8 * j; const LAS float* s = scr + (8 * c) * 33 + n;
        float sc = scale; if (ngain) sc *= ngain[n0 + n];
        u32x4 o; o.x = cvt_pk_bf16(s[0 * 33] * sc * g0.x, s[1 * 33] * sc * g0.y); o.y = cvt_pk_bf16(s[2 * 33] * sc * g0.z, s[3 * 33] * sc * g0.w);
        o.z = cvt_pk_bf16(s[4 * 33] * sc * g1.x, s[5 * 33] * sc * g1.y); o.w = cvt_pk_bf16(s[6 * 33] * sc * g1.z, s[7 * 33] * sc * g1.w);
        *(u32x4*)(WT + (size_t)(drow0 + n) * ldt + k0 + 8 * c) = o; }
    asm volatile("s_waitcnt lgkmcnt(0)" ::: "memory");
}

__device__ __forceinline__ void p0_prologue(const Frame& F, const Args& A) {
    LAS float* scr = (LAS float*)(F.lds + F.wave * 16384);
    const int gw = F.bid * 8 + F.wave, NGW = F.G * 8;
    bf16_t* WB = (bf16_t*)(F.ws + WS_W);
    const float* norm_mix = A.in[2]; const float* norm_mlp = A.in[3]; const float* norm_ple = A.in[4];
    constexpr int I_WIN = 16 * 97, I_SQ = 16 * 32, I_GRP = 4 * 4 * 8, I_W1 = 16 * 128, I_W2 = 64 * 32, I_PLE = 4 * 32;
    constexpr int NITEMS = I_WIN + 3 * I_SQ + I_GRP + 2 * I_W1 + 2 * I_W2 + 2 * I_PLE + 2 * I_SQ;
    for (int it = gw; it < NITEMS; it += NGW) {
        int r = it;
        if (r < I_WIN) {
            const int kb = r / 97, nb = r % 97, n0 = nb * 32; int drow; float sc = 1.f;
            if (n0 < 512) drow = n0; else if (n0 < 1024) { drow = NA + (n0 - 512); sc = 0.08838834764831845f; } else if (n0 < 2048) drow = NA + 512 + (n0 - 1024); else if (n0 < 3072) drow = 512 + (n0 - 2048); else drow = 1536 + (n0 - 3072);
            transpose_item(A.in[6], WIN_N, kb * 64, n0, WB + WO_WIN, 1024, drow, norm_mix, nullptr, sc, scr, F.lane); continue; }
        r -= I_WIN;
        if (r < I_SQ) { transpose_item(A.in[9], 1024, (r / 32) * 64, (r % 32) * 32, WB + WO_WOUT, 1024, (r % 32) * 32, nullptr, nullptr, 1.f, scr, F.lane); continue; }
        r -= I_SQ;
        if (r < I_SQ) { transpose_item(A.in[10], 1024, (r / 32) * 64, (r % 32) * 32, WB + WO_PIN, 1024, (r % 32) * 32, norm_mix + DM, nullptr, 1.f, scr, F.lane); continue; }
        r -= I_SQ;
        if (r < I_GRP) { const int g = r / 32, q = r % 32;
            transpose_item(A.in[11] + (size_t)g * 65536, 256, (q / 8) * 64, (q % 8) * 32, WB + WO_GRP, 256, g * 256 + (q % 8) * 32, nullptr, A.in[12] + g * 256, 1.f, scr, F.lane); continue; }
        r -= I_GRP;
        if (r < I_SQ) { transpose_item(A.in[13], 1024, (r / 32) * 64, (r % 32) * 32, WB + WO_POUT, 1024, (r % 32) * 32, nullptr, nullptr, 1.f, scr, F.lane); continue; }
        r -= I_SQ;
        if (r < 2 * I_W1) { const int l = r / I_W1, q = r % I_W1;
            transpose_item(A.in[14] + (size_t)l * 1024 * 4096, 4096, (q / 128) * 64, (q % 128) * 32, WB + WO_W1 + (size_t)l * 4096 * 1024, 1024, (q % 128) * 32, norm_mlp + l * DM, nullptr, 1.f, scr, F.lane); continue; }
        r -= 2 * I_W1;
        if (r < 2 * I_W2) { const int l = r / I_W2, q = r % I_W2;
            transpose_item(A.in[15] + (size_t)l * 1024 * 4096, 1024, (q / 32) * 64, (q % 32) * 32, WB + WO_W2 + (size_t)l * 4096 * 1024, 4096, (q % 32) * 32, nullptr, nullptr, 1.f, scr, F.lane); continue; }
        r -= 2 * I_W2;
        if (r < 2 * I_PLE) { const int l = r / I_PLE, q = r % I_PLE;
            transpose_item(A.in[16] + (size_t)l * 256 * 1024, 1024, (q / 32) * 64, (q % 32) * 32, WB + WO_PLE + (size_t)l * 1024 * 256, 256, (q % 32) * 32, nullptr, nullptr, 1.f, scr, F.lane); continue; }
        r -= 2 * I_PLE;
        { const int l = r / I_SQ, q = r % I_SQ;
            transpose_item(A.in[17] + (size_t)l * 1024 * 1024, 1024, (q / 32) * 64, (q % 32) * 32, WB + WO_GATE + (size_t)l * 1024 * 1024, 1024, (q % 32) * 32, norm_ple + l * DM, nullptr, 1.f, scr, F.lane); }
    }
    const int gt = F.bid * 512 + F.tid, NGT = F.G * 512;
    { u32x4* z = (u32x4*)(WB + WO_WIN + (size_t)1568 * 1024); const u32x4 zz = {0u, 0u, 0u, 0u};
      for (int i = gt; i < 224 * 1024 / 8; i += NGT) z[i] = zz; }
    { f32x4* z = (f32x4*)(F.ws + WS_SS) + M / 4; const f32x4 zz = {0.f, 0.f, 0.f, 0.f};
      for (int i = gt; i < 6 * M / 4; i += NGT) z[i] = zz; }
    { const float* x = A.in[0]; bf16_t* XB = (bf16_t*)(F.ws + WS_XB); float* SS = (float*)(F.ws + WS_SS);
      for (int m0 = gw * 4; m0 < M; m0 += NGW * 4) {
          f32x4 v[4][4];
#pragma unroll
          for (int r = 0; r < 4; ++r) { const f32x4* xr = (const f32x4*)(x + (size_t)(m0 + r) * DM) + F.lane;
#pragma unroll
              for (int j = 0; j < 4; ++j) v[r][j] = xr[64 * j]; }
#pragma unroll
          for (int r = 0; r < 4; ++r) { float s = 0.f;
#pragma unroll
              for (int j = 0; j < 4; ++j) s += (v[r][j].x * v[r][j].x + v[r][j].y * v[r][j].y) + (v[r][j].z * v[r][j].z + v[r][j].w * v[r][j].w);
              s = wave_sum(s, F.lane);
              u32x2* o8 = (u32x2*)(XB + (size_t)(m0 + r) * DM) + F.lane;
#pragma unroll
              for (int j = 0; j < 4; ++j) { u32x2 w; w.x = cvt_pk_bf16(v[r][j].x, v[r][j].y); w.y = cvt_pk_bf16(v[r][j].z, v[r][j].w); o8[64 * j] = w; }
              if (F.lane == 0) SS[m0 + r] = s; } } }
    { const f32x4* p = (const f32x4*)A.in[1]; u32x2* o = (u32x2*)(F.ws + WS_PB);
      for (int i = gt; i < 2 * M * PLE / 4; i += NGT * 8) { f32x4 v[8];
#pragma unroll
          for (int j = 0; j < 8; ++j) v[j] = (i + j * NGT < 2 * M * PLE / 4) ? p[i + j * NGT] : (f32x4){0.f, 0.f, 0.f, 0.f};
#pragma unroll
          for (int j = 0; j < 8; ++j) if (i + j * NGT < 2 * M * PLE / 4) { u32x2 w; w.x = cvt_pk_bf16(v[j].x, v[j].y); w.y = cvt_pk_bf16(v[j].z, v[j].w); o[i + j * NGT] = w; } } }
}

__device__ __forceinline__ float logsigmoidf_(float f) { return fminf(f, 0.f) - __logf(1.f + __expf(-fabsf(f))); }
__device__ __forceinline__ void mlstm_scan(const Frame& F, float* cst_base  ) {
    LAS float* Bc = (LAS float*)(F.lds);
    LAS float* Gc = Bc + 8192; LAS float* Pc = Gc + 8192; LAS float* Wc = Pc + 8192;
    LAS float* BL = Wc + 8192; LAS float* ML = BL + 64; LAS float* MC = ML + 64; LAS float* DEC = MC + 68;
    const float* GATES = (const float*)(F.ws + WS_GATES);
    float* TOKV = (float*)(F.ws + WS_TOKV);
    const bf16_t* KT = (const bf16_t*)(F.ws + WS_KT); const bf16_t* VT = (const bf16_t*)(F.ws + WS_VT);
    bf16_t* CST = (bf16_t*)cst_base; float* NST = (float*)(F.ws + WS_NST);
    const int lane = F.lane, wave = F.wave, fr = lane & 15, fq = lane >> 4;
    const int vb = (F.G % 8 == 0) ? (F.bid & 7) * (F.G >> 3) + (F.bid >> 3) : F.bid;
    for (int u = vb; u < 256; u += F.G) {
        const int dvs = u & 7, dir = (u >> 3) & 1, h = (u >> 4) & 3, b = u >> 6;
        const int icol = dir * 8 + h, fcol = dir * 8 + 4 + h;
        const float* gp = GATES + (size_t)b * SEQ * 16;
        float gf0[8], gi0[8], gf1[8], gi1[8];
        { const int p0 = 2 * lane, p1 = p0 + 1, o0 = dir ? 127 - p0 : p0, o1 = dir ? 127 - p1 : p1;
#pragma unroll
          for (int c8 = 0; c8 < 8; ++c8) { const int cc = wave + 8 * c8; const int oc = dir ? (NCH - 1 - cc) : cc;
              gf0[c8] = gp[(size_t)(oc * 128 + o0) * 16 + fcol]; gi0[c8] = gp[(size_t)(oc * 128 + o0) * 16 + icol];
              gf1[c8] = gp[(size_t)(oc * 128 + o1) * 16 + fcol]; gi1[c8] = gp[(size_t)(oc * 128 + o1) * 16 + icol]; } }
#pragma unroll
        for (int c8 = 0; c8 < 8; ++c8) {
            const int cc = wave + 8 * c8;
            const int p0 = 2 * lane, p1 = p0 + 1;
            const float f0 = gf0[c8], i0 = gi0[c8], f1 = gf1[c8], i1 = gi1[c8];
            const float a0 = logsigmoidf_(f0), a1 = logsigmoidf_(f1);
            float inc = a0 + a1;
#pragma unroll
            for (int o = 1; o < 64; o <<= 1) { const float t = shup(inc, o, lane); if (lane >= o) inc += t; }
            const float b0 = inc - a1, b1 = inc;
            const float g0 = i0 - b0, g1 = i1 - b1;
            float mx = fmaxf(g0, g1);
#pragma unroll
            for (int o = 1; o < 64; o <<= 1) { const float t = shup(mx, o, lane); if (lane >= o) mx = fmaxf(mx, t); }
            float exm = shup(mx, 1, lane); if (lane == 0) exm = -INFINITY;
            const float pm0 = fmaxf(exm, g0), pm1 = mx;
            Bc[cc * 128 + p0] = b0; Bc[cc * 128 + p1] = b1; Gc[cc * 128 + p0] = g0; Gc[cc * 128 + p1] = g1; Pc[cc * 128 + p0] = pm0; Pc[cc * 128 + p1] = pm1;
            if (lane == 63) { BL[cc] = b1; ML[cc] = b1 + pm1; }
        }
        __syncthreads();
        if (F.tid == 0) { float m = 0.f; MC[0] = 0.f; for (int cc = 0; cc < NCH; ++cc) { const float mn = fmaxf(BL[cc] + m, ML[cc]); DEC[cc] = __expf(BL[cc] + m - mn); m = mn; MC[cc + 1] = m; } }
        __syncthreads();
        for (int idx = F.tid; idx < SEQ; idx += 512) {
            const int cc = idx >> 7, pp = idx & 127, oc = dir ? (NCH - 1 - cc) : cc, o = dir ? 127 - pp : pp;
            const float bb = Bc[idx], g = Gc[idx], pm = Pc[idx], mc = MC[cc], mn = MC[cc + 1];
            Wc[oc * 128 + o] = __expf(BL[cc] + g - mn);
            if (dvs == 0) { const float x1 = -fmaxf(mc, pm); const size_t ti = (size_t)((b * NH + h) * 2 + dir) * SEQ + oc * 128 + o;
                TOKV[ti] = x1; TOKV[(size_t)32 * SEQ + ti] = g; TOKV[(size_t)64 * SEQ + ti] = __expf(x1 - bb); TOKV[(size_t)96 * SEQ + ti] = __expf(mc + x1); }
        }
        __syncthreads();
        const bf16_t* ktp = KT + ((size_t)((b * NH + h) * DK + 16 * wave + fr)) * SEQ + 8 * fq;
        const bf16_t* vdp = VT + ((size_t)((b * NH + h) * DV + 32 * dvs + (lane & 31))) * SEQ + 8 * (2 * wave + (lane >> 5));
        LAS unsigned char* ring = F.lds;
        const int vwo = wave * 1024 + lane * 16;
        const int vro = fr * 16 + fq * 512;
        bf16_t* cso = CST + ((size_t)((b * NH + h) * 2 + dir) * NCH) * DV * DK + (size_t)(32 * dvs + fr) * DK + 16 * wave + 4 * fq;
        float* nso = NST + ((size_t)((b * NH + h) * 2 + dir) * NCH) * DK + 16 * wave + 4 * fq;
        f32x4 c0 = {0.f, 0.f, 0.f, 0.f}, c1 = c0, cn = c0;
        const bf16x8 ones = {0x3F80, 0x3F80, 0x3F80, 0x3F80, 0x3F80, 0x3F80, 0x3F80, 0x3F80};
        u32x4 kr[4][4], vr[4];
#define SCAN_ISSUE(j, cnext) do { const int on_ = dir ? (NCH - 1 - (cnext)) : (cnext); \
            _Pragma("unroll") for (int ks = 0; ks < 4; ++ks) kr[j][ks] = *(const u32x4*)(ktp + on_ * 128 + 32 * ks); \
            vr[j] = *(const u32x4*)(vdp + on_ * 128); } while (0)
        SCAN_ISSUE(0, 0); SCAN_ISSUE(1, 1); SCAN_ISSUE(2, 2); SCAN_ISSUE(3, 3);
#define SCAN_STEP(j) do { const int cc = cb + (j); const int oc = dir ? (NCH - 1 - cc) : cc; \
            u32x4 kc[4]; _Pragma("unroll") for (int ks = 0; ks < 4; ++ks) kc[ks] = kr[j][ks]; \
            *(LAS u32x4*)(ring + (cc & 1) * 8192 + vwo) = vr[j]; \
            asm volatile("s_waitcnt lgkmcnt(0)" ::: "memory"); __builtin_amdgcn_s_barrier(); asm volatile("" ::: "memory"); \
            if (cc + 4 < NCH) SCAN_ISSUE(j, cc + 4); \
            { u32x2 w0_, w1_; w0_.x = cvt_pk_bf16(c0.x, c0.y); w0_.y = cvt_pk_bf16(c0.z, c0.w); w1_.x = cvt_pk_bf16(c1.x, c1.y); w1_.y = cvt_pk_bf16(c1.z, c1.w); \
              bf16_t* p0_ = cso + (size_t)oc * DV * DK; bf16_t* p1_ = p0_ + 16 * DK; \
              asm volatile("global_store_dwordx2 %0, %1, off\n\tglobal_store_dwordx2 %2, %3, off" :: "v"(p0_), "v"(w0_), "v"(p1_), "v"(w1_) : "memory"); \
              if (dvs == 0 && fr == 0) { float* pn_ = nso + (size_t)oc * DK; asm volatile("s_nop 7\n\ts_nop 7\n\ts_nop 7\n\tglobal_store_dwordx4 %0, %1, off\n\ts_nop 1" :: "v"(pn_), "v"(cn) : "memory"); } } \
            const float dec = DEC[cc]; \
            const LAS unsigned char* vs = ring + (cc & 1) * 8192 + vro; \
            f32x4 wv[4][2]; bf16x8 vf[4][2]; \
            _Pragma("unroll") for (int ks = 0; ks < 4; ++ks) { wv[ks][0] = *(const LAS f32x4*)(Wc + oc * 128 + 32 * ks + 8 * fq); wv[ks][1] = *(const LAS f32x4*)(Wc + oc * 128 + 32 * ks + 8 * fq + 4); \
                vf[ks][0] = *(const LAS bf16x8*)(vs + ks * 2048); vf[ks][1] = *(const LAS bf16x8*)(vs + ks * 2048 + 256); } \
            c0 = c0 * dec; c1 = c1 * dec; cn = cn * dec; \
            _Pragma("unroll") for (int ks = 0; ks < 4; ++ks) { \
                const f32x4 w0 = wv[ks][0], w1 = wv[ks][1]; \
                u32x4 kw; kw.x = cvt_pk_bf16(bf_lo(kc[ks].x) * w0.x, bf_hi(kc[ks].x) * w0.y); kw.y = cvt_pk_bf16(bf_lo(kc[ks].y) * w0.z, bf_hi(kc[ks].y) * w0.w); \
                kw.z = cvt_pk_bf16(bf_lo(kc[ks].z) * w1.x, bf_hi(kc[ks].z) * w1.y); kw.w = cvt_pk_bf16(bf_lo(kc[ks].w) * w1.z, bf_hi(kc[ks].w) * w1.w); \
                const bf16x8 af = __builtin_bit_cast(bf16x8, kw); \
                c0 = __builtin_amdgcn_mfma_f32_16x16x32_bf16(af, vf[ks][0], c0, 0, 0, 0); \
                c1 = __builtin_amdgcn_mfma_f32_16x16x32_bf16(af, vf[ks][1], c1, 0, 0, 0); \
                cn = __builtin_amdgcn_mfma_f32_16x16x32_bf16(af, ones, cn, 0, 0, 0); } } while (0)
#pragma unroll 1
        for (int cb = 0; cb < NCH; cb += 4) { SCAN_STEP(0); SCAN_STEP(1); SCAN_STEP(2); SCAN_STEP(3); }
#undef SCAN_ISSUE
#undef SCAN_STEP
        asm volatile("s_waitcnt vmcnt(0)" ::: "memory");
        __syncthreads();
    }
}

constexpr int PITCH = 272;
__device__ __forceinline__ void mlstm_out(const Frame& F, const float* head_norm, const float* cst_base) {
    LAS unsigned char* PS = F.lds; LAS unsigned char* QF = PS + 128 * PITCH; LAS unsigned char* QBk = QF + 128 * PITCH;
    LAS float* RED = (LAS float*)(QBk + 128 * PITCH);
    const float* TOKV = (const float*)(F.ws + WS_TOKV);
    const bf16_t* QB = (const bf16_t*)(F.ws + WS_QB); const bf16_t* KB = (const bf16_t*)(F.ws + WS_KB); const bf16_t* VT = (const bf16_t*)(F.ws + WS_VT);
    const bf16_t* SO = (const bf16_t*)(F.ws + WS_SO); const bf16_t* CST = (const bf16_t*)cst_base; const float* NST = (const float*)(F.ws + WS_NST);
    bf16_t* HM = (bf16_t*)(F.ws + WS_HM);
    for (int u = F.bid; u < NB * NH * NCH; u += F.G) {
        int lane_ = F.lane, wave_ = F.wave; asm volatile("" : "+v"(lane_), "+s"(wave_));
        const int lane = lane_, wave = wave_, fr = lane & 15, fq = lane >> 4;
        const int oc = u & 63, h = (u >> 6) & 3, b = u >> 8;
        const int tl = oc * 128; const size_t T0 = (size_t)b * SEQ + tl;
        const int bh = b * NH + h;
        bf16x8 Vf[2][4], Cf[2][4], Cb[2][4];
#pragma unroll
        for (int vt = 0; vt < 2; ++vt) { const int vrow = 32 * wave + 16 * vt + fr;
#pragma unroll
            for (int ks = 0; ks < 4; ++ks) {
                Vf[vt][ks] = *(const bf16x8*)(VT + ((size_t)(bh * DV + vrow)) * SEQ + tl + 32 * ks + 8 * fq);
                Cf[vt][ks] = *(const bf16x8*)(CST + (((size_t)(bh * 2 + 0) * NCH + oc) * DV + vrow) * DK + 32 * ks + 8 * fq); } }
        const int t = 16 * wave + fr;
        u32x4 Qr[4];
#pragma unroll
        for (int ks = 0; ks < 4; ++ks) Qr[ks] = *(const u32x4*)(QB + (T0 + t) * 512 + h * DK + 32 * ks + 8 * fq);
        f32x4 S[8];
        const bf16_t* kp = KB + (T0 + fr) * 512 + h * DK + 8 * fq;
#pragma unroll
        for (int st = 0; st < 8; ++st) { S[st] = (f32x4){0.f, 0.f, 0.f, 0.f};
            asm volatile("" : "+v"(kp));
#pragma unroll
            for (int ks = 0; ks < 4; ++ks) { const bf16x8 kf = *(const bf16x8*)(kp + 32 * ks);
                S[st] = __builtin_amdgcn_mfma_f32_16x16x32_bf16(kf, __builtin_bit_cast(bf16x8, Qr[ks]), S[st], 0, 0, 0); }
            kp += 16 * 512; }
        const size_t gf = (size_t)(bh * 2 + 0) * SEQ + tl, gb = (size_t)(bh * 2 + 1) * SEQ + tl;
        const float x1f = TOKV[gf + t], emf = TOKV[(size_t)64 * SEQ + gf + t], inf_ = TOKV[(size_t)96 * SEQ + gf + t];
        const float x1b = TOKV[gb + t], emb = TOKV[(size_t)64 * SEQ + gb + t], inb_ = TOKV[(size_t)96 * SEQ + gb + t];
        float sumf = 0.f, sumb = 0.f;
#pragma unroll
        for (int st = 0; st < 8; ++st) {
            const f32x4 g4f = *(const f32x4*)(TOKV + (size_t)32 * SEQ + gf + 16 * st + 4 * fq), g4b = *(const f32x4*)(TOKV + (size_t)32 * SEQ + gb + 16 * st + 4 * fq);
            const int s0 = 16 * st + 4 * fq;
            f32x4 pf, pb;
            pf.x = (s0 + 0 <= t) ? S[st].x * __expf(x1f + g4f.x) : 0.f; pf.y = (s0 + 1 <= t) ? S[st].y * __expf(x1f + g4f.y) : 0.f;
            pf.z = (s0 + 2 <= t) ? S[st].z * __expf(x1f + g4f.z) : 0.f; pf.w = (s0 + 3 <= t) ? S[st].w * __expf(x1f + g4f.w) : 0.f;
            pb.x = (s0 + 0 >= t) ? S[st].x * __expf(x1b + g4b.x) : 0.f; pb.y = (s0 + 1 >= t) ? S[st].y * __expf(x1b + g4b.y) : 0.f;
            pb.z = (s0 + 2 >= t) ? S[st].z * __expf(x1b + g4b.z) : 0.f; pb.w = (s0 + 3 >= t) ? S[st].w * __expf(x1b + g4b.w) : 0.f;
            sumf += (pf.x + pf.y) + (pf.z + pf.w); sumb += (pb.x + pb.y) + (pb.z + pb.w);
        }
        float qnf = 0.f, qnb = 0.f;
        const float* nf = NST + ((size_t)(bh * 2 + 0) * NCH + oc) * DK; const float* nb = NST + ((size_t)(bh * 2 + 1) * NCH + oc) * DK;
#pragma unroll
        for (int ks = 0; ks < 4; ++ks) {
            const f32x4 a0 = *(const f32x4*)(nf + 32 * ks + 8 * fq), a1 = *(const f32x4*)(nf + 32 * ks + 8 * fq + 4), b0 = *(const f32x4*)(nb + 32 * ks + 8 * fq), b1 = *(const f32x4*)(nb + 32 * ks + 8 * fq + 4);
            const float q0 = bf_lo(Qr[ks].x), q1 = bf_hi(Qr[ks].x), q2 = bf_lo(Qr[ks].y), q3 = bf_hi(Qr[ks].y), q4 = bf_lo(Qr[ks].z), q5 = bf_hi(Qr[ks].z), q6 = bf_lo(Qr[ks].w), q7 = bf_hi(Qr[ks].w);
            qnf += (q0 * a0.x + q1 * a0.y) + (q2 * a0.z + q3 * a0.w) + (q4 * a1.x + q5 * a1.y) + (q6 * a1.z + q7 * a1.w);
            qnb += (q0 * b0.x + q1 * b0.y) + (q2 * b0.z + q3 * b0.w) + (q4 * b1.x + q5 * b1.y) + (q6 * b1.z + q7 * b1.w);
        }
        sumf += shx(sumf, 16, lane); sumf += shx(sumf, 32, lane); sumb += shx(sumb, 16, lane); sumb += shx(sumb, 32, lane);
        qnf += shx(qnf, 16, lane); qnf += shx(qnf, 32, lane); qnb += shx(qnb, 16, lane); qnb += shx(qnb, 32, lane);
        const float rdf = 1.0f / fmaxf(fabsf(sumf + inf_ * qnf), emf), rdb = 1.0f / fmaxf(fabsf(sumb + inb_ * qnb), emb);
        asm volatile("" ::: "memory");
#pragma unroll
        for (int st = 0; st < 8; ++st) {
            const f32x4 g4f = *(const f32x4*)(TOKV + (size_t)32 * SEQ + gf + 16 * st + 4 * fq), g4b = *(const f32x4*)(TOKV + (size_t)32 * SEQ + gb + 16 * st + 4 * fq);
            const int s0 = 16 * st + 4 * fq;
            f32x4 p;
            p.x = S[st].x * (((s0 + 0 <= t) ? __expf(x1f + g4f.x) * rdf : 0.f) + ((s0 + 0 >= t) ? __expf(x1b + g4b.x) * rdb : 0.f));
            p.y = S[st].y * (((s0 + 1 <= t) ? __expf(x1f + g4f.y) * rdf : 0.f) + ((s0 + 1 >= t) ? __expf(x1b + g4b.y) * rdb : 0.f));
            p.z = S[st].z * (((s0 + 2 <= t) ? __expf(x1f + g4f.z) * rdf : 0.f) + ((s0 + 2 >= t) ? __expf(x1b + g4b.z) * rdb : 0.f));
            p.w = S[st].w * (((s0 + 3 <= t) ? __expf(x1f + g4f.w) * rdf : 0.f) + ((s0 + 3 >= t) ? __expf(x1b + g4b.w) * rdb : 0.f));
            u32x2 w; w.x = cvt_pk_bf16(p.x, p.y); w.y = cvt_pk_bf16(p.z, p.w);
            *(LAS u32x2*)(PS + t * PITCH + (16 * st + 4 * fq) * 2) = w; }
        { const float sf = inf_ * rdf, sb = inb_ * rdb;
#pragma unroll
          for (int ks = 0; ks < 4; ++ks) {
              const float q0 = bf_lo(Qr[ks].x), q1 = bf_hi(Qr[ks].x), q2 = bf_lo(Qr[ks].y), q3 = bf_hi(Qr[ks].y), q4 = bf_lo(Qr[ks].z), q5 = bf_hi(Qr[ks].z), q6 = bf_lo(Qr[ks].w), q7 = bf_hi(Qr[ks].w);
              u32x4 w; w.x = cvt_pk_bf16(q0 * sf, q1 * sf); w.y = cvt_pk_bf16(q2 * sf, q3 * sf); w.z = cvt_pk_bf16(q4 * sf, q5 * sf); w.w = cvt_pk_bf16(q6 * sf, q7 * sf);
              *(LAS u32x4*)(QF + t * PITCH + (32 * ks + 8 * fq) * 2) = w;
              w.x = cvt_pk_bf16(q0 * sb, q1 * sb); w.y = cvt_pk_bf16(q2 * sb, q3 * sb); w.z = cvt_pk_bf16(q4 * sb, q5 * sb); w.w = cvt_pk_bf16(q6 * sb, q7 * sb);
              *(LAS u32x4*)(QBk + t * PITCH + (32 * ks + 8 * fq) * 2) = w; } }
#pragma unroll
        for (int vt = 0; vt < 2; ++vt) { const int vrow = 32 * wave + 16 * vt + fr;
#pragma unroll
            for (int ks = 0; ks < 4; ++ks) Cb[vt][ks] = *(const bf16x8*)(CST + (((size_t)(bh * 2 + 1) * NCH + oc) * DV + vrow) * DK + 32 * ks + 8 * fq); }
        __syncthreads();
        f32x4 acc[8][2];
#pragma unroll
        for (int tt = 0; tt < 8; ++tt) {
            acc[tt][0] = (f32x4){0.f, 0.f, 0.f, 0.f}; acc[tt][1] = acc[tt][0];
            const int ro = (16 * tt + fr) * PITCH + 16 * fq;
#pragma unroll
            for (int ks = 0; ks < 4; ++ks) { const bf16x8 p = *(const LAS bf16x8*)(PS + ro + 64 * ks);
                acc[tt][0] = __builtin_amdgcn_mfma_f32_16x16x32_bf16(Vf[0][ks], p, acc[tt][0], 0, 0, 0); acc[tt][1] = __builtin_amdgcn_mfma_f32_16x16x32_bf16(Vf[1][ks], p, acc[tt][1], 0, 0, 0); }
#pragma unroll
            for (int ks = 0; ks < 4; ++ks) { const bf16x8 p = *(const LAS bf16x8*)(QF + ro + 64 * ks);
                acc[tt][0] = __builtin_amdgcn_mfma_f32_16x16x32_bf16(Cf[0][ks], p, acc[tt][0], 0, 0, 0); acc[tt][1] = __builtin_amdgcn_mfma_f32_16x16x32_bf16(Cf[1][ks], p, acc[tt][1], 0, 0, 0); }
        }
#pragma unroll
        for (int tt = 0; tt < 8; ++tt) {
            const int ro = (16 * tt + fr) * PITCH + 16 * fq;
#pragma unroll
            for (int ks = 0; ks < 4; ++ks) { const bf16x8 p = *(const LAS bf16x8*)(QBk + ro + 64 * ks);
                acc[tt][0] = __builtin_amdgcn_mfma_f32_16x16x32_bf16(Cb[0][ks], p, acc[tt][0], 0, 0, 0); acc[tt][1] = __builtin_amdgcn_mfma_f32_16x16x32_bf16(Cb[1][ks], p, acc[tt][1], 0, 0, 0); }
            float ss = 0.f;
#pragma unroll
            for (int vt = 0; vt < 2; ++vt) ss += (acc[tt][vt].x * acc[tt][vt].x + acc[tt][vt].y * acc[tt][vt].y) + (acc[tt][vt].z * acc[tt][vt].z + acc[tt][vt].w * acc[tt][vt].w);
            ss += shx(ss, 16, lane); ss += shx(ss, 32, lane);
            if (fq == 0) RED[wave * 128 + 16 * tt + fr] = ss;
        }
        __syncthreads();
        { const int col0 = h * DV + 32 * wave + 4 * fq;
          const f32x4 hn0 = *(const f32x4*)(head_norm + col0), hn1 = *(const f32x4*)(head_norm + col0 + 16);
          size_t off = (T0 + fr) * 1024 + col0;
#pragma unroll
          for (int tt = 0; tt < 8; ++tt) {
            asm volatile("" : "+v"(off));
            float tot = 0.f;
#pragma unroll
            for (int w = 0; w < 8; ++w) tot += RED[w * 128 + 16 * tt + fr];
            const float rstd = rsqrtf(tot * (1.f / DV) + EPS);
#pragma unroll
            for (int vt = 0; vt < 2; ++vt) {
                const f32x4 hn = vt ? hn1 : hn0; const u32x2 so = *(const u32x2*)(SO + off + 16 * vt);
                const f32x4 a = acc[tt][vt]; u32x2 w;
                w.x = cvt_pk_bf16(a.x * rstd * hn.x * bf_lo(so.x), a.y * rstd * hn.y * bf_hi(so.x)); w.y = cvt_pk_bf16(a.z * rstd * hn.z * bf_lo(so.y), a.w * rstd * hn.w * bf_hi(so.y));
                *(u32x2*)(HM + off + 16 * vt) = w; }
            off += 16 * 1024;
          } }
        __syncthreads();
    }
}

__device__ __forceinline__ void gates_direct(const Frame& F, const float* bias) {
    const bf16_t* XB = (const bf16_t*)(F.ws + WS_XB); const bf16_t* WG = (const bf16_t*)(F.ws + WS_W) + WO_WIN + (size_t)1536 * DM;
    const float* SS = (const float*)(F.ws + WS_SS); float* GATES = (float*)(F.ws + WS_GATES);
    const int lane = F.lane, fr = lane & 15, fq = lane >> 4;
    for (int tile = F.bid * 8 + F.wave; tile < M / 16; tile += F.G * 8) {
        const bf16_t* ap = XB + (size_t)(tile * 16 + fr) * DM + 8 * fq; const bf16_t* bp = WG + (size_t)fr * DM + 8 * fq;
        f32x4 acc = {0.f, 0.f, 0.f, 0.f};
#pragma unroll 8
        for (int ks = 0; ks < 32; ++ks) { const bf16x8 a = *(const bf16x8*)(ap + 32 * ks), b = *(const bf16x8*)(bp + 32 * ks);
            acc = __builtin_amdgcn_mfma_f32_16x16x32_bf16(a, b, acc, 0, 0, 0); }
        const int row0 = tile * 16 + 4 * fq; const float bv = bias[fr];
        const f32x4 s4 = *(const f32x4*)(SS + row0);
        GATES[(size_t)(row0 + 0) * 16 + fr] = acc.x * rsqrtf(s4.x * (1.f / DM) + EPS) + bv; GATES[(size_t)(row0 + 1) * 16 + fr] = acc.y * rsqrtf(s4.y * (1.f / DM) + EPS) + bv;
        GATES[(size_t)(row0 + 2) * 16 + fr] = acc.z * rsqrtf(s4.z * (1.f / DM) + EPS) + bv; GATES[(size_t)(row0 + 3) * 16 + fr] = acc.w * rsqrtf(s4.w * (1.f / DM) + EPS) + bv;
    }
}

template <int HALF>
__device__ __forceinline__ void pool_item(const bf16_t* U, bf16_t* Y0, size_t row0, int bt0, int q, int g) {
    constexpr int NR = 2 * HALF + 3;
    f32x4 r[NR];
    u32x2 w_[NR];
#pragma unroll
    for (int i = 0; i < NR; ++i) { int tt = bt0 - HALF + i; tt = tt < 0 ? 0 : (tt > SEQ - 1 ? SEQ - 1 : tt);
        w_[i] = *((const u32x2*)(U + (row0 - bt0 + tt) * 1024) + q); }
#pragma unroll
    for (int i = 0; i < NR; ++i) { const int tt = bt0 - HALF + i; const float mk = (tt >= 0 && tt < SEQ) ? 1.f : 0.f;
        r[i] = (f32x4){bf_lo(w_[i].x) * mk, bf_hi(w_[i].x) * mk, bf_lo(w_[i].y) * mk, bf_hi(w_[i].y) * mk}; }
#pragma unroll
    for (int j = 0; j < 4; ++j) { const int t = bt0 + j; int lo = t - HALF; if (lo < 0) lo = 0; int hi = t + HALF; if (hi > SEQ) hi = SEQ;
        f32x4 sum = r[j];
#pragma unroll
        for (int i = 1; i < 2 * HALF; ++i) sum += r[j + i];
        const f32x4 y = sum * (1.0f / (float)(hi - lo)) - r[j + HALF];
        u32x2 w; w.x = cvt_pk_bf16(y.x, y.y); w.y = cvt_pk_bf16(y.z, y.w);
        *((u32x2*)(Y0 + ((size_t)g * M + row0 + j) * 256) + (q & 63)) = w; }
}
__device__ __forceinline__ void pool_phase(const Frame& F) {
    const bf16_t* U1 = (const bf16_t*)(F.ws + WS_U1); bf16_t* Y0 = (bf16_t*)(F.ws + WS_Y0);
    const int gt = F.bid * 512 + F.tid, NGT = F.G * 512;
    for (int it = gt; it < (M / 4) * 256; it += NGT) {
        const int q = it & 255, tb = it >> 8; const int g = q >> 6;
        const size_t row0 = (size_t)tb * 4; const int bt0 = (int)(row0 & (SEQ - 1));
        if (g == 0) pool_item<1>(U1, Y0, row0, bt0, q, g); else if (g == 1) pool_item<2>(U1, Y0, row0, bt0, q, g);
        else if (g == 2) pool_item<4>(U1, Y0, row0, bt0, q, g); else pool_item<8>(U1, Y0, row0, bt0, q, g);
    }
}

__device__ __forceinline__ void final_phase(const Frame& F, const float* gain, const float* ss, const bf16_t* hb) {
    const int gw = F.bid * 8 + F.wave, NGW = F.G * 8;
    const f32x4* gr = (const f32x4*)gain + F.lane;
    for (int m0 = gw * 4; m0 < M; m0 += NGW * 4) {
        u32x2 w[4][4]; float r[4];
#pragma unroll
        for (int q = 0; q < 4; ++q) { const u32x2* hr = (const u32x2*)(hb + (size_t)(m0 + q) * DM) + F.lane; r[q] = rsqrtf(ss[m0 + q] * (1.f / DM) + EPS);
#pragma unroll
            for (int j = 0; j < 4; ++j) w[q][j] = hr[64 * j]; }
#pragma unroll
        for (int q = 0; q < 4; ++q) { f32x4* xr = (f32x4*)(F.out + (size_t)(m0 + q) * DM) + F.lane;
#pragma unroll
            for (int j = 0; j < 4; ++j) { const f32x4 v = {bf_lo(w[q][j].x), bf_hi(w[q][j].x), bf_lo(w[q][j].y), bf_hi(w[q][j].y)}; xr[64 * j] = v * r[q] * gr[64 * j]; } }
    }
}

#define XB_TMO      128
#define XB_XCNT(j)  (256  + 64 * (j))
#define XB_XSUB(j)  (1280 + 64 * (j))
#define XB_XGEN(j)  (2304 + 64 * (j))
#define XB_TOP      3328
#define XB_TOPGEN   3392
#define XCD_BAR_WORDS 3456
#define XB_SPIN_CAP (1u << 22)
__device__ __forceinline__ unsigned xb_ld(unsigned* p)              { return __hip_atomic_load(p, __ATOMIC_RELAXED, __HIP_MEMORY_SCOPE_AGENT); }
__device__ __forceinline__ unsigned xb_add(unsigned* p, unsigned v) { return __hip_atomic_fetch_add(p, v, __ATOMIC_RELAXED, __HIP_MEMORY_SCOPE_AGENT); }
__device__ __forceinline__ unsigned xb_xcc_id() { return (unsigned)__builtin_amdgcn_s_getreg((3 << 11) | 20) & 0xFu; }
#define XB_SPIN(cond, bar) do { unsigned _sp = 0; while (cond) { __builtin_amdgcn_s_sleep(1); \
    if ((++_sp & 255u) == 0u) { if (xb_ld(&(bar)[XB_TMO])) break; if (_sp > XB_SPIN_CAP) { atomicAdd(&(bar)[XB_TMO], 1u); break; } } } } while (0)
__device__ __forceinline__ void xcd_barrier_complete(unsigned* bar, unsigned x, unsigned& nloc, unsigned& nx) {
    const unsigned G = gridDim.x;
    unsigned sum, cnt, mine, sp = 0u;
    for (;;) {
        sum = 0u; cnt = 0u; mine = 0u;
#pragma unroll
        for (unsigned j = 0; j < 16; ++j) { const unsigned c = xb_ld(&bar[XB_XCNT(j)]); sum += c; cnt += (c > 0u) ? 1u : 0u; mine = (j == x) ? c : mine; }
        if (sum == G) break;
        __builtin_amdgcn_s_sleep(1);
        if ((++sp & 255u) == 0u) { if (xb_ld(&bar[XB_TMO])) break; if (sp > XB_SPIN_CAP) { atomicAdd(&bar[XB_TMO], 1u); break; } }
    }
    nloc = mine > 0u ? mine : 1u; nx = cnt > 0u ? cnt : 1u;
}
__device__ __forceinline__ void xcd_barrier(unsigned* bar, volatile LAS unsigned* st, int tid) {
    asm volatile("s_waitcnt vmcnt(0)" ::: "memory");
    __syncthreads();
    if (tid == 0) {
        __builtin_amdgcn_s_waitcnt(0);
        const unsigned x = xb_xcc_id();
        unsigned nloc = st[0], nx = st[1];
        if (nloc == 0u) { xcd_barrier_complete(bar, x, nloc, nx); st[0] = nloc; st[1] = nx; }
        const unsigned old = xb_add(&bar[XB_XSUB(x)], 1u);
        const unsigned gen = old / nloc;
        if (old + 1u == (gen + 1u) * nloc) {
            __builtin_amdgcn_fence(__ATOMIC_RELEASE, "agent");
            asm volatile("s_waitcnt vmcnt(0)" ::: "memory");
            const unsigned og = xb_add(&bar[XB_TOP], 1u);
            const unsigned tg = og / nx;
            if (og + 1u == (tg + 1u) * nx) xb_add(&bar[XB_TOPGEN], 1u);
            else XB_SPIN(xb_ld(&bar[XB_TOPGEN]) == tg, bar);
            __builtin_amdgcn_fence(__ATOMIC_ACQUIRE, "agent");
            xb_add(&bar[XB_XGEN(x)], 1u);
            asm volatile("s_waitcnt vmcnt(0)" ::: "memory");
        } else {
            XB_SPIN(xb_ld(&bar[XB_XGEN(x)]) == gen, bar);
            __builtin_amdgcn_fence(__ATOMIC_ACQUIRE, "agent");
            asm volatile("s_waitcnt vmcnt(0)" ::: "memory");
        }
    }
    __syncthreads();
}

constexpr int N_PHASES = 15;
typedef const __attribute__((address_space(4))) Args* KArgP;
__device__ __forceinline__ Args load_args_() {
    Args a{};
#if defined(__HIP_DEVICE_COMPILE__)
    KArgP p_ = (KArgP)__builtin_amdgcn_kernarg_segment_ptr(); asm volatile("" : "+s"(p_));
#pragma unroll
    for (int i = 0; i < 19; ++i) a.in[i] = p_->in[i];
    a.out = p_->out; a.ws = p_->ws; a.ph_lo = p_->ph_lo; a.ph_hi = p_->ph_hi;
#endif
    return a;
}
#define LOADARGS() load_args_()
#define MKFRAME(A) Frame F; F.lds = (LAS unsigned char*)lds_raw; { int l_ = lane_id_fresh(); F.lane = l_; int b_ = blockIdx.x; asm volatile("" : "+s"(b_)); F.bid = b_; } F.wave = wvid; F.tid = wvid * 64 + F.lane; F.G = gridDim.x; F.ws = (A).ws; F.out = (A).out; \
    unsigned char* ws = (A).ws; bf16_t* WB = (bf16_t*)(ws + WS_W); float* SS = (float*)(ws + WS_SS); bf16_t* XB = (bf16_t*)(ws + WS_XB); bf16_t* XB2 = (bf16_t*)(ws + WS_Y1); bf16_t* HMb = (bf16_t*)(ws + WS_HM); bf16_t* PB = (bf16_t*)(ws + WS_PB); bf16_t* ACT = (bf16_t*)(ws + WS_ACT); \
    (void)WB; (void)SS; (void)XB; (void)XB2; (void)HMb; (void)PB; (void)ACT;
__global__ void __launch_bounds__(512, 2) mk_fwd(Args args) {
    extern __shared__ __attribute__((aligned(16))) unsigned char lds_raw[];
    const int lo = args.ph_lo, hi = args.ph_hi;
#define LCTL ((volatile LAS unsigned*)((LAS unsigned char*)lds_raw + (LDS_BYTES - 64)))
    if (threadIdx.x == 0) { LCTL[0] = 0u; LCTL[1] = 0u; LCTL[2] = 0u; }
    __syncthreads();
    int wvid;
    { const int l0 = lane_id_fresh(); unsigned w = 0u;
      if (l0 == 0) w = __hip_atomic_fetch_add((LAS unsigned*)((LAS unsigned char*)lds_raw + (LDS_BYTES - 64)), 1u, __ATOMIC_RELAXED, __HIP_MEMORY_SCOPE_WORKGROUP);
      wvid = __builtin_amdgcn_readfirstlane((int)w);
      if (MK_MULTI == 0 && wvid == 0 && l0 == 0) (void)xb_add((unsigned*)args.ws + XB_XCNT(xb_xcc_id()), 1u); }
#ifndef PH_MASK
#define PH_MASK 0xFFFF
#endif
#define IN(k) ((((PH_MASK) >> (k)) & 1) && lo <= (k) && (k) < hi)
#define SEAM(k) do { if (lo <= (k) && (k) + 1 < hi) { if ((k) == 0) cg::this_grid().sync(); else { const Args A_ = LOADARGS(); int l_ = lane_id_fresh(); xcd_barrier((unsigned*)A_.ws, LCTL + 1, wvid * 64 + l_); } } } while (0)

    if (IN(0)) { const Args A = LOADARGS(); MKFRAME(A); p0_prologue(F, A); }
    SEAM(0);
    if (IN(1)) {
        const Args A = LOADARGS(); MKFRAME(A);
        gates_direct(F, A.in[7]);
        { pg8::Gemm g{XB, WB + WO_WIN, M, 1536, DM, 0}; pg8::StaticOrder S; S.init(M, 1536, F.G, F.bid);
          Epi<EP_QO> E; E.a = EpiArgs{}; E.a.ss_in = SS; E.a.qb = (bf16_t*)(ws + WS_QB); E.a.so = (bf16_t*)(ws + WS_SO); E.a.gates = (float*)(ws + WS_GATES); E.a.bias = A.in[7];
          pg8::gemm_phase(F.lds, g, S, E, wvid * 64 + lane_id_fresh()); }
        { pg8::Gemm g{XB, WB + WO_WIN + (size_t)NA * DM, M, NBK, DM, 0}; pg8::StaticOrder S; S.init(M, NBK, F.G, F.bid);
          Epi<EP_KV> E; E.a = EpiArgs{}; E.a.ss_in = SS; E.a.kb = (bf16_t*)(ws + WS_KB); E.a.kt = (bf16_t*)(ws + WS_KT); E.a.vt = (bf16_t*)(ws + WS_VT);
          pg8::gemm_phase(F.lds, g, S, E, wvid * 64 + lane_id_fresh()); }
    }
    SEAM(1);
    if (IN(2)) { const Args A = LOADARGS(); MKFRAME(A); mlstm_scan(F, A.out); }
    SEAM(2);
    if (IN(3)) { const Args A = LOADARGS(); MKFRAME(A); mlstm_out(F, A.in[8], A.out); }
    SEAM(3);
    if (IN(4)) {
        const Args A = LOADARGS(); MKFRAME(A);
        pg8::Gemm g{HMb, WB + WO_WOUT, M, DM, DM, 0}; pg8::StaticOrder S; S.init(M, DM, F.G, F.bid);
        Epi<EP_RES32> E; E.a = EpiArgs{}; E.a.res32 = A.in[0]; E.a.xbo = XB; E.a.ss_out = SS + 1 * M;
        pg8::gemm_phase(F.lds, g, S, E, F.tid);
    }
    SEAM(4);
#pragma unroll
    for (int l = 0; l < 2; ++l) {
        const int pb = 5 + 7 * l;
        if (l == 1) {
            if (IN(8)) {
                const Args A = LOADARGS(); MKFRAME(A);
                pg8::Gemm g{XB2, WB + WO_PIN, M, DM, DM, 0}; pg8::StaticOrder S; S.init(M, DM, F.G, F.bid);
                Epi<EP_BF16S> E; E.a = EpiArgs{}; E.a.ss_in = SS + 3 * M; E.a.o16 = (bf16_t*)(ws + WS_U1); E.a.ldc = DM;
                pg8::gemm_phase(F.lds, g, S, E, F.tid);
            }
            SEAM(8);
            if (IN(9)) { const Args A = LOADARGS(); MKFRAME(A); pool_phase(F); }
            SEAM(9);
            if (IN(10)) {
                const Args A = LOADARGS(); MKFRAME(A);
                pg8::Gemm g{(const bf16_t*)(ws + WS_Y0), WB + WO_GRP, M, DM, 256, (size_t)M * 256}; pg8::StaticOrder S; S.init(M, DM, F.G, F.bid);
                Epi<EP_BF16> E; E.a = EpiArgs{}; E.a.o16 = HMb; E.a.ldc = DM;
                pg8::gemm_phase(F.lds, g, S, E, F.tid);
            }
            SEAM(10);
            if (IN(11)) {
                const Args A = LOADARGS(); MKFRAME(A);
                pg8::Gemm g{HMb, WB + WO_POUT, M, DM, DM, 0}; pg8::StaticOrder S; S.init(M, DM, F.G, F.bid);
                Epi<EP_RES> E; E.a = EpiArgs{}; E.a.res16 = XB2; E.a.xbo = XB; E.a.ss_out = SS + 4 * M;
                pg8::gemm_phase(F.lds, g, S, E, F.tid);
            }
            SEAM(11);
        }
        const int si = 1 + 3 * l;
        if (IN(pb)) {
            const Args A = LOADARGS(); MKFRAME(A);
            { pg8::Gemm g{XB, WB + WO_W1 + (size_t)l * FF * DM, M, FF, DM, 0}; pg8::StaticOrder S; S.init(M, FF, F.G, F.bid);
              Epi<EP_SQRELU> E; E.a = EpiArgs{}; E.a.ss_in = SS + si * M; E.a.o16 = ACT; E.a.ldc = FF;
              pg8::gemm_phase(F.lds, g, S, E, F.tid); }
            { pg8::Gemm g{PB + (size_t)l * M * PLE, WB + WO_PLE + (size_t)l * DM * PLE, M, DM, PLE, 0}; pg8::StaticOrder S; S.init(M, DM, F.G, F.bid);
              Epi<EP_BF16> E; E.a = EpiArgs{}; E.a.o16 = HMb; E.a.ldc = DM;
              pg8::gemm_phase(F.lds, g, S, E, wvid * 64 + lane_id_fresh()); }
        }
        SEAM(pb);
        if (IN(pb + 1)) {
            const Args A = LOADARGS(); MKFRAME(A);
            pg8::Gemm g{ACT, WB + WO_W2 + (size_t)l * FF * DM, M, DM, FF, 0}; pg8::StaticOrder S; S.init(M, DM, F.G, F.bid);
            Epi<EP_RES> E; E.a = EpiArgs{}; E.a.res16 = XB; E.a.xbo = XB; E.a.ss_out = SS + (si + 1) * M;
            pg8::gemm_phase(F.lds, g, S, E, F.tid);
        }
        SEAM(pb + 1);
        if (IN(pb + 2)) {
            const Args A = LOADARGS(); MKFRAME(A);
            pg8::Gemm g{XB, WB + WO_GATE + (size_t)l * DM * DM, M, DM, DM, 0}; pg8::StaticOrder S; S.init(M, DM, F.G, F.bid);
            Epi<EP_GATE> E; E.a = EpiArgs{}; E.a.ss_in = SS + (si + 1) * M; E.a.res16 = XB; E.a.xbo = XB2; E.a.ss_out = SS + (si + 2) * M;
            E.a.bias = A.in[18] + l * DM; E.a.pe = HMb;
            pg8::gemm_phase(F.lds, g, S, E, F.tid);
        }
        SEAM(pb + 2);
    }
    if (IN(15)) { const Args A = LOADARGS(); MKFRAME(A); final_phase(F, A.in[5], SS + 6 * M, XB2); }
#undef IN
#undef SEAM
}

extern "C" void kernel_launch(void* const* d_in, const int* in_sizes, int n_in, void* d_out, int out_size, void* d_ws, size_t ws_size, hipStream_t stream) {
    static int grid = 0;
    if (grid == 0) {
        if (n_in != 19 || out_size != M * DM || ws_size < WS_END) { fprintf(stderr, "kernel_launch: unexpected shapes (n_in %d out %d ws %zu)\n", n_in, out_size, ws_size); grid = -1; return; }
        int dev = 0, cus = 0, per_cu = 0;
        hipGetDevice(&dev); hipDeviceGetAttribute(&cus, hipDeviceAttributeMultiprocessorCount, dev);
        hipFuncSetAttribute((const void*)mk_fwd, hipFuncAttributeMaxDynamicSharedMemorySize, LDS_BYTES);
        if (hipOccupancyMaxActiveBlocksPerMultiprocessor(&per_cu, (const void*)mk_fwd, 512, LDS_BYTES) != hipSuccess || per_cu < 1) { fprintf(stderr, "kernel_launch: occupancy query gave %d\n", per_cu); per_cu = 1; }
        (void)hipGetLastError();
        grid = cus * per_cu;
        fprintf(stderr, "kernel_launch: grid %d (cus %d per_cu %d)\n", grid, cus, per_cu);
    }
    if (grid < 0) return;
    Args a{};
    for (int i = 0; i < 19; ++i) a.in[i] = (const float*)d_in[i];
    a.out = (float*)d_out; a.ws = (unsigned char*)d_ws;
    hipMemsetAsync(d_ws, 0, 16384, stream);
#if MK_MULTI
    for (int ph = 0; ph <= N_PHASES; ++ph) { a.ph_lo = ph; a.ph_hi = ph + 1; hipLaunchKernelGGL(mk_fwd, dim3(grid), dim3(512), LDS_BYTES, stream, a); }
#else
    a.ph_lo = 0; a.ph_hi = N_PHASES + 1;
    void* kargs[] = {&a};
    hipError_t e = hipLaunchCooperativeKernel((const void*)mk_fwd, dim3(grid), dim3(512), kargs, LDS_BYTES, stream);
    if (e != hipSuccess) fprintf(stderr, "cooperative launch failed: %s (grid %d)\n", hipGetErrorString(e), grid);
#ifdef PROBE_LIST
    { const int pl[] = {PROBE_LIST}; for (int ph : pl) { Args b = a; b.out = (float*)((unsigned char*)d_ws + WS_U1); b.ph_lo = ph; b.ph_hi = ph + 1; hipLaunchKernelGGL(mk_fwd, dim3(grid), dim3(512), LDS_BYTES, stream, b); } }
#endif
#endif
}
```

```cpp
#include <hip/hip_runtime.h>
#include <hip/hip_cooperative_groups.h>
#include <cstdio>
#include <cstdint>
namespace cg = cooperative_groups;

#ifndef MK_MULTI
#define MK_MULTI 0
#endif

#define LAS __attribute__((address_space(3)))
typedef unsigned short bf16_t;
typedef short bf16x8 __attribute__((ext_vector_type(8)));
typedef float f32x4 __attribute__((ext_vector_type(4)));
typedef float f32x2 __attribute__((ext_vector_type(2)));
typedef unsigned u32x4 __attribute__((ext_vector_type(4)));
typedef unsigned u32x2 __attribute__((ext_vector_type(2)));

constexpr int DM = 1024, NB = 4, SEQ = 8192, M = NB * SEQ, FF = 4096, PLE = 256;
constexpr int NH = 4, DK = 128, DV = 256, LCH = 128, NCH = SEQ / LCH;
constexpr int WIN_N = 3088;
constexpr int NA = 1792, NBK = 1536;
constexpr float EPS = 1e-6f;

constexpr size_t MiB = 1u << 20;
constexpr size_t WS_GATES = 1 * MiB;
constexpr size_t WS_SS = 3 * MiB;
constexpr size_t WS_NST = 4 * MiB;
constexpr size_t WS_TOKV = 5 * MiB;
constexpr size_t WS_W = 10 * MiB;
constexpr size_t WS_XB = 64 * MiB;
constexpr size_t WS_PB = 128 * MiB;
constexpr size_t WS_HM = 160 * MiB;
constexpr size_t WS_U = 224 * MiB;
constexpr size_t WS_QB = WS_U, WS_KB = WS_U + 32 * MiB, WS_KT = WS_U + 64 * MiB, WS_VT = WS_U + 96 * MiB, WS_SO = WS_U + 160 * MiB;
constexpr size_t WS_ACT = 224 * MiB;
constexpr size_t WS_U1 = 224 * MiB;
constexpr size_t WS_Y0 = 352 * MiB;
constexpr size_t WS_Y1 = 416 * MiB;
constexpr size_t WS_END = 480 * MiB;
constexpr size_t WO_WIN = 0;
constexpr size_t WO_WOUT = WO_WIN + (size_t)3328 * 1024;
constexpr size_t WO_PIN = WO_WOUT + (size_t)1024 * 1024;
constexpr size_t WO_GRP = WO_PIN + (size_t)1024 * 1024;
constexpr size_t WO_POUT = WO_GRP + (size_t)1024 * 256;
constexpr size_t WO_W1 = WO_POUT + (size_t)1024 * 1024;
constexpr size_t WO_W2 = WO_W1 + (size_t)2 * 4096 * 1024;
constexpr size_t WO_PLE = WO_W2 + (size_t)2 * 4096 * 1024;
constexpr size_t WO_GATE = WO_PLE + (size_t)2 * 1024 * 256;
constexpr size_t WO_END = WO_GATE + (size_t)2 * 1024 * 1024;
static_assert(WS_W + WO_END * 2 <= WS_XB, "weights fit");

constexpr int LDS_BYTES = 147456;

__device__ __forceinline__ unsigned cvt_pk_bf16(float lo, float hi) { unsigned r; asm volatile("v_cvt_pk_bf16_f32 %0, %1, %2" : "=v"(r) : "v"(lo), "v"(hi)); return r; }
__device__ __forceinline__ float bf_lo(unsigned w) { return __uint_as_float(w << 16); }
__device__ __forceinline__ float bf_hi(unsigned w) { return __uint_as_float(w & 0xffff0000u); }
__device__ __forceinline__ float sigmoidf_(float v) { return 1.0f / (1.0f + __expf(-v)); }

__device__ __forceinline__ float shx(float v, int mask, int lane) { return __int_as_float(__builtin_amdgcn_ds_bpermute((lane ^ mask) << 2, __float_as_int(v))); }
__device__ __forceinline__ float shup(float v, int d, int lane) { return __int_as_float(__builtin_amdgcn_ds_bpermute((lane - d) << 2, __float_as_int(v))); }
__device__ __forceinline__ int lane_id_fresh() { unsigned m = ~0u; asm volatile("" : "+s"(m)); return (int)__builtin_amdgcn_mbcnt_hi(m, __builtin_amdgcn_mbcnt_lo(m, 0u)); }
namespace pg8 {
constexpr int BM = 256, BK = 64, HALF = 128, HTB = HALF * BK * 2, STAGE_BYTES = 8 * HTB, NXCD = 8, WGM = 8;
__host__ __device__ __forceinline__ int lds_byte(int r, int c) { const int st = (r >> 4) * 2 + (c >> 5), rr = r & 15, cc = c & 31, ob = rr * 64 + cc * 2; return st * 1024 + (ob ^ (((ob >> 9) & 1) << 5)); }
__host__ __device__ __forceinline__ void stage_rc(int b, int& R, int& C) { const int st = b / 1024, sb = b % 1024, swz = sb ^ (((sb >> 9) & 1) << 5); R = (st >> 1) * 16 + swz / 64; C = (st & 1) * 32 + (swz % 64) / 2; }
__host__ __device__ __forceinline__ int perm32(int rho) { const int n = rho >> 4, i = rho & 15; return 8 * (i >> 2) + 4 * n + (i & 3); }

struct Unit { int pm, pn; };
struct Gemm { const bf16_t* A; const bf16_t* Bt; int M, N, K; size_t acol; };

struct StaticOrder {
    int nM, nN, nwg, G, c;
    __device__ void init(int M_, int N_, int G_, int c_) { nM = M_ / BM; nN = N_ / BM; nwg = nM * nN; G = G_; c = c_; }
    __device__ bool next(int i, Unit& u) const {
        const long L = (long)i * G + c; if (L >= nwg) return false;
        int wgid = (int)L; { const int q = nwg / NXCD, r = nwg % NXCD, xcd = wgid % NXCD, off = wgid / NXCD; wgid = (xcd < r ? xcd * (q + 1) : r * (q + 1) + (xcd - r) * q) + off; }
        const int nig = WGM * nN, gid = wgid / nig, fm = gid * WGM, gsz = (nM - fm) < WGM ? (nM - fm) : WGM;
        u.pm = fm + ((wgid % nig) % gsz); u.pn = (wgid % nig) / gsz; return true;
    }
};

template <class Epi>
__device__ __forceinline__ void gemm_phase(LAS unsigned char* lds, const Gemm g, const StaticOrder& S, const Epi& E, int tid_in) {
    int tid_ = tid_in; asm volatile("" : "+v"(tid_));
    const int tid = tid_, wid = __builtin_amdgcn_readfirstlane(tid >> 6), lane = tid & 63, wr = wid >> 2, wc = wid & 3, fr = lane & 15, fq = lane >> 4;
    const int K = g.K, nt = K / BK;
    unsigned voffA[2], voffB[2];
#pragma unroll
    for (int i = 0; i < 2; ++i) { int R, C; stage_rc(tid * 16 + i * 8192, R, C); const int Rb = Epi::PERM ? ((R & ~31) + perm32(R & 31)) : R;
        voffA[i] = (unsigned)(R * K + C) * 2u; voffB[i] = (unsigned)(Rb * K + C) * 2u; }
    const size_t kstep = (size_t)(BK * 2);
    const size_t hstep = (size_t)HALF * K * 2;
    const size_t tstep = 2 * hstep;
    const unsigned ldsw = (unsigned)wid * 1024u;
    const int aoff = lds_byte(wr * 64 + fr, fq * 8), boff = lds_byte(wc * 32 + fr, fq * 8);
#define PG8_SA(b, h) (((b) * 2 + (h)) * HTB)
#define PG8_SB(b, h) ((4 + (b) * 2 + (h)) * HTB)
#define PG8_STAGE(bufoff, gbase, voff) do { const char* gb_ = (const char*)(gbase); asm volatile("" : "+s"(gb_));   \
        _Pragma("unroll") for (int _i = 0; _i < 2; ++_i) \
        __builtin_amdgcn_global_load_lds((const unsigned*)(gb_ + (voff)[_i]), (LAS unsigned*)(lds + (bufoff) + ldsw + _i * 8192), 16, 0, 0); } while (0)
#define PG8_LDA(dst, b, h) do { _Pragma("unroll") for (int m = 0; m < 4; ++m) _Pragma("unroll") for (int k = 0; k < 2; ++k) dst[m][k] = *(const LAS bf16x8*)(lds + PG8_SA(b, h) + aoff + m * 2048 + k * 1024); } while (0)
#define PG8_LDB(dst, b, h) do { _Pragma("unroll") for (int n = 0; n < 2; ++n) _Pragma("unroll") for (int k = 0; k < 2; ++k) dst[n][k] = *(const LAS bf16x8*)(lds + PG8_SB(b, h) + boff + n * 2048 + k * 1024); } while (0)
#define PG8_MMA(ai, bj, At, Bt) do { __builtin_amdgcn_s_setprio(1); _Pragma("unroll") for (int m = 0; m < 4; ++m) _Pragma("unroll") for (int n = 0; n < 2; ++n) _Pragma("unroll") for (int k = 0; k < 2; ++k) \
        acc[ai][bj][m][n] = Epi::SWAP ? __builtin_amdgcn_mfma_f32_16x16x32_bf16(At[m][k], Bt[n][k], acc[ai][bj][m][n], 0, 0, 0) \
                                      : __builtin_amdgcn_mfma_f32_16x16x32_bf16(Bt[n][k], At[m][k], acc[ai][bj][m][n], 0, 0, 0); __builtin_amdgcn_s_setprio(0); } while (0)
#define PG8_WAIT_V(n) asm volatile("s_waitcnt vmcnt(" #n ")" ::: "memory")
#define PG8_WAIT_L(n) asm volatile("s_waitcnt lgkmcnt(" #n ")" ::: "memory")
#define PG8_BAR __builtin_amdgcn_s_barrier()
#define PG8_SCHED __builtin_amdgcn_sched_barrier(0)
    Unit cur, nxt; int ui = 0;
    if (!S.next(0, cur)) return;
    f32x4 acc[2][2][4][2];
#pragma unroll
    for (int a = 0; a < 2; ++a)
#pragma unroll
        for (int b = 0; b < 2; ++b)
#pragma unroll
            for (int m = 0; m < 4; ++m)
#pragma unroll
                for (int n = 0; n < 2; ++n) acc[a][b][m][n] = (f32x4){0.f, 0.f, 0.f, 0.f};
    bf16x8 At[4][2], B0[2][2], B1[2][2];
    const char* cA = (const char*)g.A + (size_t)cur.pm * tstep + (size_t)cur.pn * g.acol * 2; const char* cB = (const char*)g.Bt + (size_t)cur.pn * tstep;
    PG8_STAGE(PG8_SB(0, 0), cB, voffB); PG8_STAGE(PG8_SB(0, 1), cB + hstep, voffB); PG8_STAGE(PG8_SA(0, 0), cA, voffA); PG8_STAGE(PG8_SA(0, 1), cA + hstep, voffA);
    if (wr == 1) PG8_BAR;
    PG8_WAIT_V(2); PG8_BAR;
    PG8_STAGE(PG8_SB(1, 0), cB + kstep, voffB); PG8_STAGE(PG8_SA(1, 0), cA + kstep, voffA); PG8_STAGE(PG8_SB(1, 1), cB + hstep + kstep, voffB);
    PG8_WAIT_V(6); PG8_BAR;
    for (;;) {
        const bool has_next = S.next(ui + 1, nxt);
        const char* nA = has_next ? (const char*)g.A + (size_t)nxt.pm * tstep + (size_t)nxt.pn * g.acol * 2 : cA; const char* nB = has_next ? (const char*)g.Bt + (size_t)nxt.pn * tstep : cB;
        for (int t = 0; t < nt; t += 2) {
            const bool last = (t == nt - 2);
            const char* a1 = cA + (size_t)(t + 1) * kstep;
            const char* a2 = last ? nA : cA + (size_t)(t + 2) * kstep; const char* b2 = last ? nB : cB + (size_t)(t + 2) * kstep;
            const char* a3 = a2 + kstep; const char* b3 = b2 + kstep;
            PG8_LDB(B0, 0, 0); PG8_LDB(B1, 0, 1); PG8_SCHED; PG8_LDA(At, 0, 0); PG8_STAGE(PG8_SA(1, 1), a1 + hstep, voffA);
            PG8_WAIT_V(8); PG8_WAIT_L(0); PG8_BAR; PG8_MMA(0, 0, At, B0); PG8_MMA(0, 1, At, B1); PG8_BAR; PG8_SCHED;
            PG8_LDA(At, 0, 1); PG8_STAGE(PG8_SB(0, 0), b2, voffB); PG8_STAGE(PG8_SB(0, 1), b2 + hstep, voffB); PG8_STAGE(PG8_SA(0, 0), a2, voffA);
            PG8_WAIT_V(8); PG8_WAIT_L(0); PG8_BAR; PG8_MMA(1, 0, At, B0); PG8_MMA(1, 1, At, B1); PG8_BAR; PG8_SCHED;
            PG8_LDB(B0, 1, 0); PG8_LDB(B1, 1, 1); PG8_SCHED; PG8_LDA(At, 1, 0); PG8_STAGE(PG8_SA(0, 1), a2 + hstep, voffA);
            PG8_WAIT_V(8); PG8_WAIT_L(0); PG8_BAR; PG8_MMA(0, 0, At, B0); PG8_MMA(0, 1, At, B1); PG8_BAR; PG8_SCHED;
            PG8_LDA(At, 1, 1); PG8_STAGE(PG8_SB(1, 0), b3, voffB); PG8_STAGE(PG8_SB(1, 1), b3 + hstep, voffB); PG8_STAGE(PG8_SA(1, 0), a3, voffA);
            PG8_WAIT_V(8); PG8_WAIT_L(0); PG8_BAR; PG8_MMA(1, 0, At, B0); PG8_MMA(1, 1, At, B1); PG8_BAR; PG8_SCHED;
        }
        if (wr == 0) PG8_BAR;
        const int lane2 = lane_id_fresh();
        E(acc, cur, wr, wc, lane2 & 15, lane2 >> 4);
        if (!has_next) break;
        { int t2 = wid * 64 + lane_id_fresh();
#pragma unroll
          for (int i = 0; i < 2; ++i) { int R, C; stage_rc(t2 * 16 + i * 8192, R, C); const int Rb = Epi::PERM ? ((R & ~31) + perm32(R & 31)) : R;
              voffA[i] = (unsigned)(R * K + C) * 2u; voffB[i] = (unsigned)(Rb * K + C) * 2u; } }
#pragma unroll
        for (int a = 0; a < 2; ++a)
#pragma unroll
            for (int b = 0; b < 2; ++b)
#pragma unroll
                for (int m = 0; m < 4; ++m)
#pragma unroll
                    for (int n = 0; n < 2; ++n) acc[a][b][m][n] = (f32x4){0.f, 0.f, 0.f, 0.f};
        cur = nxt; cA = nA; cB = nB; ++ui;
        if (wr == 1) PG8_BAR;
    }
    PG8_WAIT_V(0);
    PG8_BAR;
#undef PG8_SA
#undef PG8_SB
#undef PG8_STAGE
#undef PG8_LDA
#undef PG8_LDB
#undef PG8_MMA
#undef PG8_WAIT_V
#undef PG8_WAIT_L
#undef PG8_BAR
#undef PG8_SCHED
}
}

enum { EP_QO = 0, EP_KV, EP_RES, EP_GATE, EP_SQRELU, EP_BF16, EP_F32SCALE, EP_RES32, EP_BF16S };
struct EpiArgs {
    const float* ss_in;
    const float* res32;
    const bf16_t* res16;
    bf16_t* xbo;
    float* ss_out;
    const float* bias;
    const bf16_t* pe;
    bf16_t* o16; int ldc;
    float* o32;
    bf16_t *qb, *kb, *kt, *vt, *so; float* gates;
};
template <int MODE> struct Epi {
    static constexpr bool PERM = (MODE != EP_KV), SWAP = (MODE == EP_KV);
    EpiArgs a;
    __device__ __forceinline__ void operator()(const f32x4 (&acc)[2][2][4][2], const pg8::Unit& u, int wr, int wc, int fr_, int fq_) const {
        int fr = fr_, fq = fq_; asm volatile("" : "+v"(fr), "+v"(fq));
        if constexpr (MODE == EP_KV) {
#pragma unroll
            for (int ai = 0; ai < 2; ++ai)
#pragma unroll
                for (int m = 0; m < 4; ++m) {
                    const int row0 = u.pm * 256 + ai * 128 + wr * 64 + m * 16 + 4 * fq;
                    const f32x4 s4 = *(const f32x4*)(a.ss_in + row0);
                    f32x4 r4; r4.x = rsqrtf(s4.x * (1.f / DM) + EPS); r4.y = rsqrtf(s4.y * (1.f / DM) + EPS); r4.z = rsqrtf(s4.z * (1.f / DM) + EPS); r4.w = rsqrtf(s4.w * (1.f / DM) + EPS);
                    const int b = row0 >> 13, tok = row0 & 8191;
#pragma unroll
                    for (int bj = 0; bj < 2; ++bj)
#pragma unroll
                        for (int n = 0; n < 2; ++n) {
                            const int col = u.pn * 256 + bj * 128 + wc * 32 + 16 * n + fr;
                            const f32x4 v = acc[ai][bj][m][n] * r4;
                            u32x2 w; w.x = cvt_pk_bf16(v.x, v.y); w.y = cvt_pk_bf16(v.z, v.w);
                            if (u.pn < 2) {
                                const int hd = col >> 7, dk = col & 127;
                                *(u32x2*)(a.kt + ((size_t)((b * NH + hd) * DK + dk)) * SEQ + tok) = w;
                                bf16_t* kr = a.kb + (size_t)row0 * 512 + col;
                                kr[0] = (bf16_t)(w.x & 0xffff); kr[512] = (bf16_t)(w.x >> 16); kr[1024] = (bf16_t)(w.y & 0xffff); kr[1536] = (bf16_t)(w.y >> 16);
                            } else {
                                const int vc = col - 512, hd = vc >> 8, dv = vc & 255;
                                *(u32x2*)(a.vt + ((size_t)((b * NH + hd) * DV + dv)) * SEQ + tok) = w;
                            }
                        }
                }
        } else {
            const int rowb = u.pm * 256 + wr * 64 + fr, colb = u.pn * 256 + wc * 32 + 8 * fq;
#pragma unroll
            for (int ai = 0; ai < 2; ++ai)
#pragma unroll
                for (int m = 0; m < 4; ++m) {
                    const int row = rowb + ai * 128 + m * 16;
                    float rs = 1.f;
                    if constexpr (MODE == EP_QO || MODE == EP_GATE || MODE == EP_SQRELU || MODE == EP_F32SCALE || MODE == EP_BF16S) rs = rsqrtf(a.ss_in[row] * (1.f / DM) + EPS);
                    float ssq = 0.f;
#pragma unroll
                    for (int bj = 0; bj < 2; ++bj) {
                        const int col = colb + bj * 128;
                        f32x4 v0 = acc[ai][bj][m][0] * rs, v1 = acc[ai][bj][m][1] * rs;
                        if constexpr (MODE == EP_QO) {
                            if (u.pn < 2) {
                                u32x4 w; w.x = cvt_pk_bf16(v0.x, v0.y); w.y = cvt_pk_bf16(v0.z, v0.w); w.z = cvt_pk_bf16(v1.x, v1.y); w.w = cvt_pk_bf16(v1.z, v1.w);
                                *(u32x4*)(a.qb + (size_t)row * 512 + col) = w;
                            } else if (u.pn < 6) {
                                u32x4 w; w.x = cvt_pk_bf16(sigmoidf_(v0.x), sigmoidf_(v0.y)); w.y = cvt_pk_bf16(sigmoidf_(v0.z), sigmoidf_(v0.w));
                                w.z = cvt_pk_bf16(sigmoidf_(v1.x), sigmoidf_(v1.y)); w.w = cvt_pk_bf16(sigmoidf_(v1.z), sigmoidf_(v1.w));
                                *(u32x4*)(a.so + (size_t)row * 1024 + (col - 512)) = w;
                            } else {
                                if (bj == 0 && wc == 0 && fq < 2) {
                                    const f32x4 b0 = *(const f32x4*)(a.bias + 8 * fq), b1 = *(const f32x4*)(a.bias + 8 * fq + 4);
                                    *(f32x4*)(a.gates + (size_t)row * 16 + 8 * fq) = v0 + b0; *(f32x4*)(a.gates + (size_t)row * 16 + 8 * fq + 4) = v1 + b1;
                                }
                            }
                        } else if constexpr (MODE == EP_SQRELU) {
                            v0.x = fmaxf(v0.x, 0.f); v0.y = fmaxf(v0.y, 0.f); v0.z = fmaxf(v0.z, 0.f); v0.w = fmaxf(v0.w, 0.f);
                            v1.x = fmaxf(v1.x, 0.f); v1.y = fmaxf(v1.y, 0.f); v1.z = fmaxf(v1.z, 0.f); v1.w = fmaxf(v1.w, 0.f);
                            v0 = v0 * v0; v1 = v1 * v1;
                            u32x4 w; w.x = cvt_pk_bf16(v0.x, v0.y); w.y = cvt_pk_bf16(v0.z, v0.w); w.z = cvt_pk_bf16(v1.x, v1.y); w.w = cvt_pk_bf16(v1.z, v1.w);
                            *(u32x4*)(a.o16 + (size_t)row * a.ldc + col) = w;
                        } else if constexpr (MODE == EP_BF16 || MODE == EP_BF16S) {
                            u32x4 w; w.x = cvt_pk_bf16(v0.x, v0.y); w.y = cvt_pk_bf16(v0.z, v0.w); w.z = cvt_pk_bf16(v1.x, v1.y); w.w = cvt_pk_bf16(v1.z, v1.w);
                            *(u32x4*)(a.o16 + (size_t)row * a.ldc + col) = w;
                        } else if constexpr (MODE == EP_F32SCALE) {
                            *(f32x4*)(a.o32 + (size_t)row * DM + col) = v0; *(f32x4*)(a.o32 + (size_t)row * DM + col + 4) = v1;
                        } else {
                            const size_t off = (size_t)row * DM + col;
                            f32x4 r0, r1;
                            if constexpr (MODE == EP_RES32) { r0 = *(const f32x4*)(a.res32 + off); r1 = *(const f32x4*)(a.res32 + off + 4); }
                            else { const u32x4 rw = *(const u32x4*)(a.res16 + off); r0 = (f32x4){bf_lo(rw.x), bf_hi(rw.x), bf_lo(rw.y), bf_hi(rw.y)}; r1 = (f32x4){bf_lo(rw.z), bf_hi(rw.z), bf_lo(rw.w), bf_hi(rw.w)}; }
                            if constexpr (MODE == EP_GATE) {
                                const f32x4 b0 = *(const f32x4*)(a.bias + col), b1 = *(const f32x4*)(a.bias + col + 4);
                                const u32x4 pw = *(const u32x4*)(a.pe + off);
                                v0 = v0 + b0; v1 = v1 + b1;
                                v0.x = sigmoidf_(v0.x) * bf_lo(pw.x); v0.y = sigmoidf_(v0.y) * bf_hi(pw.x); v0.z = sigmoidf_(v0.z) * bf_lo(pw.y); v0.w = sigmoidf_(v0.w) * bf_hi(pw.y);
                                v1.x = sigmoidf_(v1.x) * bf_lo(pw.z); v1.y = sigmoidf_(v1.y) * bf_hi(pw.z); v1.z = sigmoidf_(v1.z) * bf_lo(pw.w); v1.w = sigmoidf_(v1.w) * bf_hi(pw.w);
                            }
                            v0 = v0 + r0; v1 = v1 + r1;
                            u32x4 w; w.x = cvt_pk_bf16(v0.x, v0.y); w.y = cvt_pk_bf16(v0.z, v0.w); w.z = cvt_pk_bf16(v1.x, v1.y); w.w = cvt_pk_bf16(v1.z, v1.w);
                            *(u32x4*)(a.xbo + off) = w;
                            v0 = (f32x4){bf_lo(w.x), bf_hi(w.x), bf_lo(w.y), bf_hi(w.y)}; v1 = (f32x4){bf_lo(w.z), bf_hi(w.z), bf_lo(w.w), bf_hi(w.w)};
                            ssq += (v0.x * v0.x + v0.y * v0.y) + (v0.z * v0.z + v0.w * v0.w) + (v1.x * v1.x + v1.y * v1.y) + (v1.z * v1.z + v1.w * v1.w);
                        }
                    }
                    if constexpr (MODE == EP_RES || MODE == EP_RES32 || MODE == EP_GATE) {
                        const int ln_ = fq * 16 + fr; ssq += shx(ssq, 16, ln_); ssq += shx(ssq, 32, ln_);
                        if (fq == 0) atomicAdd(a.ss_out + row, ssq);
                    }
                    asm volatile("" ::: "memory");
                }
        }
    }
};

struct Args { const float* in[19]; float* out; unsigned char* ws; int ph_lo, ph_hi; };
struct Frame {
    LAS unsigned char* lds; int tid, lane, wave, G, bid;
    unsigned char* ws; float* out;
};

__device__ __forceinline__ float wave_sum(float v, int lane) {
#pragma unroll
    for (int o = 1; o < 64; o <<= 1) v += shx(v, o, lane);
    return v;
}

__device__ __forceinline__ void transpose_item(const float* W, int N, int k0, int n0, bf16_t* WT, int ldt, int drow0, const float* kgain, const float* ngain, float scale, LAS float* scr, int lane) {
    const int nn = n0 + (lane & 31);
    float v[32];
#pragma unroll
    for (int i = 0; i < 32; ++i) v[i] = (nn < N) ? W[(size_t)(k0 + 2 * i + (lane >> 5)) * N + nn] : 0.f;
#pragma unroll
    for (int i = 0; i < 32; ++i) scr[(2 * i + (lane >> 5)) * 33 + (lane & 31)] = v[i];
    asm volatile("s_waitcnt lgkmcnt(0)" ::: "memory");
    const int c = lane & 7;
    f32x4 g0 = {1.f, 1.f, 1.f, 1.f}, g1 = g0;
    if (kgain) { g0 = *(const f32x4*)(kgain + k0 + 8 * c); g1 = *(const f32x4*)(kgain + k0 + 8 * c + 4); }
#pragma unroll
    for (int j = 0; j < 4; ++j) { const int n = (lane >> 3) + 8 * j; const LAS float* s = scr + (8 * c) * 33 + n;
        float sc = scale; if (ngain) sc *= ngain[n0 + n];
        u32x4 o; o.x = cvt_pk_bf16(s[0 * 33] * sc * g0.x, s[1 * 33] * sc * g0.y); o.y = cvt_pk_bf16(s[2 * 33] * sc * g0.z, s[3 * 33] * sc * g0.w);
        o.z = cvt_pk_bf16(s[4 * 33] * sc * g1.x, s[5 * 33] * sc * g1.y); o.w = cvt_pk_bf16(s[6 * 33] * sc * g1.z, s[7 * 33] * sc * g1.w);
        *(u32x4*)(WT + (size_t)(drow0 + n) * ldt + k0 + 8 * c) = o; }
    asm volatile("s_waitcnt lgkmcnt(0)" ::: "memory");
}

__device__ __forceinline__ void p0_prologue(const Frame& F, const Args& A) {
    LAS float* scr = (LAS float*)(F.lds + F.wave * 16384);
    const int gw = F.bid * 8 + F.wave, NGW = F.G * 8;
    bf16_t* WB = (bf16_t*)(F.ws + WS_W);
    const float* norm_mix = A.in[2]; const float* norm_mlp = A.in[3]; const float* norm_ple = A.in[4];
    constexpr int I_WIN = 16 * 97, I_SQ = 16 * 32, I_GRP = 4 * 4 * 8, I_W1 = 16 * 128, I_W2 = 64 * 32, I_PLE = 4 * 32;
    constexpr int NITEMS = I_WIN + 3 * I_SQ + I_GRP + 2 * I_W1 + 2 * I_W2 + 2 * I_PLE + 2 * I_SQ;
    for (int it = gw; it < NITEMS; it += NGW) {
        int r = it;
        if (r < I_WIN) {
            const int kb = r / 97, nb = r % 97, n0 = nb * 32; int drow; float sc = 1.f;
            if (n0 < 512) drow = n0; else if (n0 < 1024) { drow = NA + (n0 - 512); sc = 0.08838834764831845f; } else if (n0 < 2048) drow = NA + 512 + (n0 - 1024); else if (n0 < 3072) drow = 512 + (n0 - 2048); else drow = 1536 + (n0 - 3072);
            transpose_item(A.in[6], WIN_N, kb * 64, n0, WB + WO_WIN, 1024, drow, norm_mix, nullptr, sc, scr, F.lane); continue; }
        r -= I_WIN;
        if (r < I_SQ) { transpose_item(A.in[9], 1024, (r / 32) * 64, (r % 32) * 32, WB + WO_WOUT, 1024, (r % 32) * 32, nullptr, nullptr, 1.f, scr, F.lane); continue; }
        r -= I_SQ;
        if (r < I_SQ) { transpose_item(A.in[10], 1024, (r / 32) * 64, (r % 32) * 32, WB + WO_PIN, 1024, (r % 32) * 32, norm_mix + DM, nullptr, 1.f, scr, F.lane); continue; }
        r -= I_SQ;
        if (r < I_GRP) { const int g = r / 32, q = r % 32;
            transpose_item(A.in[11] + (size_t)g * 65536, 256, (q / 8) * 64, (q % 8) * 32, WB + WO_GRP, 256, g * 256 + (q % 8) * 32, nullptr, A.in[12] + g * 256, 1.f, scr, F.lane); continue; }
        r -= I_GRP;
        if (r < I_SQ) { transpose_item(A.in[13], 1024, (r / 32) * 64, (r % 32) * 32, WB + WO_POUT, 1024, (r % 32) * 32, nullptr, nullptr, 1.f, scr, F.lane); continue; }
        r -= I_SQ;
        if (r < 2 * I_W1) { const int l = r / I_W1, q = r % I_W1;
            transpose_item(A.in[14] + (size_t)l * 1024 * 4096, 4096, (q / 128) * 64, (q % 128) * 32, WB + WO_W1 + (size_t)l * 4096 * 1024, 1024, (q % 128) * 32, norm_mlp + l * DM, nullptr, 1.f, scr, F.lane); continue; }
        r -= 2 * I_W1;
        if (r < 2 * I_W2) { const int l = r / I_W2, q = r % I_W2;
            transpose_item(A.in[15] + (size_t)l * 1024 * 4096, 1024, (q / 32) * 64, (q % 32) * 32, WB + WO_W2 + (size_t)l * 4096 * 1024, 4096, (q % 32) * 32, nullptr, nullptr, 1.f, scr, F.lane); continue; }
        r -= 2 * I_W2;
        if (r < 2 * I_PLE) { const int l = r / I_PLE, q = r % I_PLE;
            transpose_item(A.in[16] + (size_t)l * 256 * 1024, 1024, (q / 32) * 64, (q % 32) * 32, WB + WO_PLE + (size_t)l * 1024 * 256, 256, (q % 32) * 32, nullptr, nullptr, 1.f, scr, F.lane); continue; }
        r -= 2 * I_PLE;
        { const int l = r / I_SQ, q = r % I_SQ;
            transpose_item(A.in[17] + (size_t)l * 1024 * 1024, 1024, (q / 32) * 64, (q % 32) * 32, WB + WO_GATE + (size_t)l * 1024 * 1024, 1024, (q % 32) * 32, norm_ple + l * DM, nullptr, 1.f, scr, F.lane); }
    }
    const int gt = F.bid * 512 + F.tid, NGT = F.G * 512;
    { u32x4* z = (u32x4*)(WB + WO_WIN + (size_t)1568 * 1024); const u32x4 zz = {0u, 0u, 0u, 0u};
      for (int i = gt; i < 224 * 1024 / 8; i += NGT) z[i] = zz; }
    { f32x4* z = (f32x4*)(F.ws + WS_SS) + M / 4; const f32x4 zz = {0.f, 0.f, 0.f, 0.f};
      for (int i = gt; i < 6 * M / 4; i += NGT) z[i] = zz; }
    { const float* x = A.in[0]; bf16_t* XB = (bf16_t*)(F.ws + WS_XB); float* SS = (float*)(F.ws + WS_SS);
      for (int m0 = gw * 4; m0 < M; m0 += NGW * 4) {
          f32x4 v[4][4];
#pragma unroll
          for (int r = 0; r < 4; ++r) { const f32x4* xr = (const f32x4*)(x + (size_t)(m0 + r) * DM) + F.lane;
#pragma unroll
              for (int j = 0; j < 4; ++j) v[r][j] = xr[64 * j]; }
#pragma unroll
          for (int r = 0; r < 4; ++r) { float s = 0.f;
#pragma unroll
              for (int j = 0; j < 4; ++j) s += (v[r][j].x * v[r][j].x + v[r][j].y * v[r][j].y) + (v[r][j].z * v[r][j].z + v[r][j].w * v[r][j].w);
              s = wave_sum(s, F.lane);
              u32x2* o8 = (u32x2*)(XB + (size_t)(m0 + r) * DM) + F.lane;
#pragma unroll
              for (int j = 0; j < 4; ++j) { u32x2 w; w.x = cvt_pk_bf16(v[r][j].x, v[r][j].y); w.y = cvt_pk_bf16(v[r][j].z, v[r][j].w); o8[64 * j] = w; }
              if (F.lane == 0) SS[m0 + r] = s; } } }
    { const f32x4* p = (const f32x4*)A.in[1]; u32x2* o = (u32x2*)(F.ws + WS_PB);
      for (int i = gt; i < 2 * M * PLE / 4; i += NGT * 8) { f32x4 v[8];
#pragma unroll
          for (int j = 0; j < 8; ++j) v[j] = (i + j * NGT < 2 * M * PLE / 4) ? p[i + j * NGT] : (f32x4){0.f, 0.f, 0.f, 0.f};
#pragma unroll
          for (int j = 0; j < 8; ++j) if (i + j * NGT < 2 * M * PLE / 4) { u32x2 w; w.x = cvt_pk_bf16(v[j].x, v[j].y); w.y = cvt_pk_bf16(v[j].z, v[j].w); o[i + j * NGT] = w; } } }
}

__device__ __forceinline__ float logsigmoidf_(float f) { return fminf(f, 0.f) - __logf(1.f + __expf(-fabsf(f))); }
__device__ __forceinline__ void mlstm_scan(const Frame& F, float* cst_base  ) {
    LAS float* Bc = (LAS float*)(F.lds);
    LAS float* Gc = Bc + 8192; LAS float* Pc = Gc + 8192; LAS float* Wc = Pc + 8192;
    LAS float* BL = Wc + 8192; LAS float* ML = BL + 64; LAS float* MC = ML + 64; LAS float* DEC = MC + 68;
    const float* GATES = (const float*)(F.ws + WS_GATES);
    float* TOKV = (float*)(F.ws + WS_TOKV);
    const bf16_t* KT = (const bf16_t*)(F.ws + WS_KT); const bf16_t* VT = (const bf16_t*)(F.ws + WS_VT);
    bf16_t* CST = (bf16_t*)cst_base; float* NST = (float*)(F.ws + WS_NST);
    const int lane = F.lane, wave = F.wave, fr = lane & 15, fq = lane >> 4;
    const int vb = (F.G % 8 == 0) ? (F.bid & 7) * (F.G >> 3) + (F.bid >> 3) : F.bid;
    for (int u = vb; u < 256; u += F.G) {
        const int dvs = u & 7, dir = (u >> 3) & 1, h = (u >> 4) & 3, b = u >> 6;
        const int icol = dir * 8 + h, fcol = dir * 8 + 4 + h;
        const float* gp = GATES + (size_t)b * SEQ * 16;
        for (int cc = wave; cc < NCH; cc += 8) {
            const int oc = dir ? (NCH - 1 - cc) : cc;
            const int p0 = 2 * lane, p1 = p0 + 1, o0 = dir ? 127 - p0 : p0, o1 = dir ? 127 - p1 : p1;
            const float f0 = gp[(size_t)(oc * 128 + o0) * 16 + fcol], i0 = gp[(size_t)(oc * 128 + o0) * 16 + icol];
            const float f1 = gp[(size_t)(oc * 128 + o1) * 16 + fcol], i1 = gp[(size_t)(oc * 128 + o1) * 16 + icol];
            const float a0 = logsigmoidf_(f0), a1 = logsigmoidf_(f1);
            float inc = a0 + a1;
#pragma unroll
            for (int o = 1; o < 64; o <<= 1) { const float t = shup(inc, o, lane); if (lane >= o) inc += t; }
            const float b0 = inc - a1, b1 = inc;
            const float g0 = i0 - b0, g1 = i1 - b1;
            float mx = fmaxf(g0, g1);
#pragma unroll
            for (int o = 1; o < 64; o <<= 1) { const float t = shup(mx, o, lane); if (lane >= o) mx = fmaxf(mx, t); }
            float exm = shup(mx, 1, lane); if (lane == 0) exm = -INFINITY;
            const float pm0 = fmaxf(exm, g0), pm1 = mx;
            Bc[cc * 128 + p0] = b0; Bc[cc * 128 + p1] = b1; Gc[cc * 128 + p0] = g0; Gc[cc * 128 + p1] = g1; Pc[cc * 128 + p0] = pm0; Pc[cc * 128 + p1] = pm1;
            if (lane == 63) { BL[cc] = b1; ML[cc] = b1 + pm1; }
        }
        __syncthreads();
        if (F.tid == 0) { float m = 0.f; MC[0] = 0.f; for (int cc = 0; cc < NCH; ++cc) { const float mn = fmaxf(BL[cc] + m, ML[cc]); DEC[cc] = __expf(BL[cc] + m - mn); m = mn; MC[cc + 1] = m; } }
        __syncthreads();
        for (int idx = F.tid; idx < SEQ; idx += 512) {
            const int cc = idx >> 7, pp = idx & 127, oc = dir ? (NCH - 1 - cc) : cc, o = dir ? 127 - pp : pp;
            const float bb = Bc[idx], g = Gc[idx], pm = Pc[idx], mc = MC[cc], mn = MC[cc + 1];
            Wc[oc * 128 + o] = __expf(BL[cc] + g - mn);
            if (dvs == 0) { const float x1 = -fmaxf(mc, pm); const size_t ti = (size_t)((b * NH + h) * 2 + dir) * SEQ + oc * 128 + o;
                TOKV[ti] = x1; TOKV[(size_t)32 * SEQ + ti] = g; TOKV[(size_t)64 * SEQ + ti] = __expf(x1 - bb); TOKV[(size_t)96 * SEQ + ti] = __expf(mc + x1); }
        }
        __syncthreads();
        const bf16_t* ktp = KT + ((size_t)((b * NH + h) * DK + 16 * wave + fr)) * SEQ + 8 * fq;
        const bf16_t* vdp = VT + ((size_t)((b * NH + h) * DV + 32 * dvs + (lane & 31))) * SEQ + 8 * (2 * wave + (lane >> 5));
        LAS unsigned char* ring = F.lds;
        const int vwo = wave * 1024 + lane * 16;
        const int vro = fr * 16 + fq * 512;
        bf16_t* cso = CST + ((size_t)((b * NH + h) * 2 + dir) * NCH) * DV * DK + (size_t)(32 * dvs + fr) * DK + 16 * wave + 4 * fq;
        float* nso = NST + ((size_t)((b * NH + h) * 2 + dir) * NCH) * DK + 16 * wave + 4 * fq;
        f32x4 c0 = {0.f, 0.f, 0.f, 0.f}, c1 = c0, cn = c0;
        const bf16x8 ones = {0x3F80, 0x3F80, 0x3F80, 0x3F80, 0x3F80, 0x3F80, 0x3F80, 0x3F80};
        u32x4 kr[4][4], vr[4];
#define SCAN_ISSUE(j, cnext) do { const int on_ = dir ? (NCH - 1 - (cnext)) : (cnext); \
            _Pragma("unroll") for (int ks = 0; ks < 4; ++ks) kr[j][ks] = *(const u32x4*)(ktp + on_ * 128 + 32 * ks); \
            vr[j] = *(const u32x4*)(vdp + on_ * 128); } while (0)
        SCAN_ISSUE(0, 0); SCAN_ISSUE(1, 1); SCAN_ISSUE(2, 2); SCAN_ISSUE(3, 3);
#define SCAN_STEP(j) do { const int cc = cb + (j); const int oc = dir ? (NCH - 1 - cc) : cc; \
            u32x4 kc[4]; _Pragma("unroll") for (int ks = 0; ks < 4; ++ks) kc[ks] = kr[j][ks]; \
            *(LAS u32x4*)(ring + (cc & 1) * 8192 + vwo) = vr[j]; \
            asm volatile("s_waitcnt lgkmcnt(0)" ::: "memory"); __builtin_amdgcn_s_barrier(); asm volatile("" ::: "memory"); \
            if (cc + 4 < NCH) SCAN_ISSUE(j, cc + 4); \
            { u32x2 w0_, w1_; w0_.x = cvt_pk_bf16(c0.x, c0.y); w0_.y = cvt_pk_bf16(c0.z, c0.w); w1_.x = cvt_pk_bf16(c1.x, c1.y); w1_.y = cvt_pk_bf16(c1.z, c1.w); \
              bf16_t* p0_ = cso + (size_t)oc * DV * DK; bf16_t* p1_ = p0_ + 16 * DK; \
              asm volatile("global_store_dwordx2 %0, %1, off\n\tglobal_store_dwordx2 %2, %3, off" :: "v"(p0_), "v"(w0_), "v"(p1_), "v"(w1_) : "memory"); \
              if (dvs == 0 && fr == 0) { float* pn_ = nso + (size_t)oc * DK; asm volatile("s_nop 7\n\ts_nop 7\n\ts_nop 7\n\tglobal_store_dwordx4 %0, %1, off\n\ts_nop 1" :: "v"(pn_), "v"(cn) : "memory"); } } \
            const float dec = DEC[cc]; \
            const LAS unsigned char* vs = ring + (cc & 1) * 8192 + vro; \
            f32x4 wv[4][2]; bf16x8 vf[4][2]; \
            _Pragma("unroll") for (int ks = 0; ks < 4; ++ks) { wv[ks][0] = *(const LAS f32x4*)(Wc + oc * 128 + 32 * ks + 8 * fq); wv[ks][1] = *(const LAS f32x4*)(Wc + oc * 128 + 32 * ks + 8 * fq + 4); \
                vf[ks][0] = *(const LAS bf16x8*)(vs + ks * 2048); vf[ks][1] = *(const LAS bf16x8*)(vs + ks * 2048 + 256); } \
            c0 = c0 * dec; c1 = c1 * dec; cn = cn * dec; \
            _Pragma("unroll") for (int ks = 0; ks < 4; ++ks) { \
                const f32x4 w0 = wv[ks][0], w1 = wv[ks][1]; \
                u32x4 kw; kw.x = cvt_pk_bf16(bf_lo(kc[ks].x) * w0.x, bf_hi(kc[ks].x) * w0.y); kw.y = cvt_pk_bf16(bf_lo(kc[ks].y) * w0.z, bf_hi(kc[ks].y) * w0.w); \
                kw.z = cvt_pk_bf16(bf_lo(kc[ks].z) * w1.x, bf_hi(kc[ks].z) * w1.y); kw.w = cvt_pk_bf16(bf_lo(kc[ks].w) * w1.z, bf_hi(kc[ks].w) * w1.w); \
                const bf16x8 af = __builtin_bit_cast(bf16x8, kw); \
                c0 = __builtin_amdgcn_mfma_f32_16x16x32_bf16(af, vf[ks][0], c0, 0, 0, 0); \
                c1 = __builtin_amdgcn_mfma_f32_16x16x32_bf16(af, vf[ks][1], c1, 0, 0, 0); \
                cn = __builtin_amdgcn_mfma_f32_16x16x32_bf16(af, ones, cn, 0, 0, 0); } } while (0)
#pragma unroll 1
        for (int cb = 0; cb < NCH; cb += 4) { SCAN_STEP(0); SCAN_STEP(1); SCAN_STEP(2); SCAN_STEP(3); }
#undef SCAN_ISSUE
#undef SCAN_STEP
        asm volatile("s_waitcnt vmcnt(0)" ::: "memory");
        __syncthreads();
    }
}

constexpr int PITCH = 272;
__device__ __forceinline__ void mlstm_out(const Frame& F, const float* head_norm, const float* cst_base) {
    LAS unsigned char* PS = F.lds; LAS unsigned char* QF = PS + 128 * PITCH; LAS unsigned char* QBk = QF + 128 * PITCH;
    LAS float* RED = (LAS float*)(QBk + 128 * PITCH);
    const float* TOKV = (const float*)(F.ws + WS_TOKV);
    const bf16_t* QB = (const bf16_t*)(F.ws + WS_QB); const bf16_t* KB = (const bf16_t*)(F.ws + WS_KB); const bf16_t* VT = (const bf16_t*)(F.ws + WS_VT);
    const bf16_t* SO = (const bf16_t*)(F.ws + WS_SO); const bf16_t* CST = (const bf16_t*)cst_base; const float* NST = (const float*)(F.ws + WS_NST);
    bf16_t* HM = (bf16_t*)(F.ws + WS_HM);
    for (int u = F.bid; u < NB * NH * NCH; u += F.G) {
        int lane_ = F.lane, wave_ = F.wave; asm volatile("" : "+v"(lane_), "+s"(wave_));
        const int lane = lane_, wave = wave_, fr = lane & 15, fq = lane >> 4;
        const int oc = u & 63, h = (u >> 6) & 3, b = u >> 8;
        const int tl = oc * 128; const size_t T0 = (size_t)b * SEQ + tl;
        const int bh = b * NH + h;
        bf16x8 Vf[2][4], Cf[2][4], Cb[2][4];
#pragma unroll
        for (int vt = 0; vt < 2; ++vt) { const int vrow = 32 * wave + 16 * vt + fr;
#pragma unroll
            for (int ks = 0; ks < 4; ++ks) {
                Vf[vt][ks] = *(const bf16x8*)(VT + ((size_t)(bh * DV + vrow)) * SEQ + tl + 32 * ks + 8 * fq);
                Cf[vt][ks] = *(const bf16x8*)(CST + (((size_t)(bh * 2 + 0) * NCH + oc) * DV + vrow) * DK + 32 * ks + 8 * fq); } }
        const int t = 16 * wave + fr;
        u32x4 Qr[4];
#pragma unroll
        for (int ks = 0; ks < 4; ++ks) Qr[ks] = *(const u32x4*)(QB + (T0 + t) * 512 + h * DK + 32 * ks + 8 * fq);
        f32x4 S[8];
        const bf16_t* kp = KB + (T0 + fr) * 512 + h * DK + 8 * fq;
#pragma unroll
        for (int st = 0; st < 8; ++st) { S[st] = (f32x4){0.f, 0.f, 0.f, 0.f};
            asm volatile("" : "+v"(kp));
#pragma unroll
            for (int ks = 0; ks < 4; ++ks) { const bf16x8 kf = *(const bf16x8*)(kp + 32 * ks);
                S[st] = __builtin_amdgcn_mfma_f32_16x16x32_bf16(kf, __builtin_bit_cast(bf16x8, Qr[ks]), S[st], 0, 0, 0); }
            kp += 16 * 512; }
        const size_t gf = (size_t)(bh * 2 + 0) * SEQ + tl, gb = (size_t)(bh * 2 + 1) * SEQ + tl;
        const float x1f = TOKV[gf + t], emf = TOKV[(size_t)64 * SEQ + gf + t], inf_ = TOKV[(size_t)96 * SEQ + gf + t];
        const float x1b = TOKV[gb + t], emb = TOKV[(size_t)64 * SEQ + gb + t], inb_ = TOKV[(size_t)96 * SEQ + gb + t];
        float sumf = 0.f, sumb = 0.f;
#pragma unroll
        for (int st = 0; st < 8; ++st) {
            const f32x4 g4f = *(const f32x4*)(TOKV + (size_t)32 * SEQ + gf + 16 * st + 4 * fq), g4b = *(const f32x4*)(TOKV + (size_t)32 * SEQ + gb + 16 * st + 4 * fq);
            const int s0 = 16 * st + 4 * fq;
            f32x4 pf, pb;
            pf.x = (s0 + 0 <= t) ? S[st].x * __expf(x1f + g4f.x) : 0.f; pf.y = (s0 + 1 <= t) ? S[st].y * __expf(x1f + g4f.y) : 0.f;
            pf.z = (s0 + 2 <= t) ? S[st].z * __expf(x1f + g4f.z) : 0.f; pf.w = (s0 + 3 <= t) ? S[st].w * __expf(x1f + g4f.w) : 0.f;
            pb.x = (s0 + 0 >= t) ? S[st].x * __expf(x1b + g4b.x) : 0.f; pb.y = (s0 + 1 >= t) ? S[st].y * __expf(x1b + g4b.y) : 0.f;
            pb.z = (s0 + 2 >= t) ? S[st].z * __expf(x1b + g4b.z) : 0.f; pb.w = (s0 + 3 >= t) ? S[st].w * __expf(x1b + g4b.w) : 0.f;
            sumf += (pf.x + pf.y) + (pf.z + pf.w); sumb += (pb.x + pb.y) + (pb.z + pb.w);
        }
        float qnf = 0.f, qnb = 0.f;
        const float* nf = NST + ((size_t)(bh * 2 + 0) * NCH + oc) * DK; const float* nb = NST + ((size_t)(bh * 2 + 1) * NCH + oc) * DK;
#pragma unroll
        for (int ks = 0; ks < 4; ++ks) {
            const f32x4 a0 = *(const f32x4*)(nf + 32 * ks + 8 * fq), a1 = *(const f32x4*)(nf + 32 * ks + 8 * fq + 4), b0 = *(const f32x4*)(nb + 32 * ks + 8 * fq), b1 = *(const f32x4*)(nb + 32 * ks + 8 * fq + 4);
            const float q0 = bf_lo(Qr[ks].x), q1 = bf_hi(Qr[ks].x), q2 = bf_lo(Qr[ks].y), q3 = bf_hi(Qr[ks].y), q4 = bf_lo(Qr[ks].z), q5 = bf_hi(Qr[ks].z), q6 = bf_lo(Qr[ks].w), q7 = bf_hi(Qr[ks].w);
            qnf += (q0 * a0.x + q1 * a0.y) + (q2 * a0.z + q3 * a0.w) + (q4 * a1.x + q5 * a1.y) + (q6 * a1.z + q7 * a1.w);
            qnb += (q0 * b0.x + q1 * b0.y) + (q2 * b0.z + q3 * b0.w) + (q4 * b1.x + q5 * b1.y) + (q6 * b1.z + q7 * b1.w);
        }
        sumf += shx(sumf, 16, lane); sumf += shx(sumf, 32, lane); sumb += shx(sumb, 16, lane); sumb += shx(sumb, 32, lane);
        qnf += shx(qnf, 16, lane); qnf += shx(qnf, 32, lane); qnb += shx(qnb, 16, lane); qnb += shx(qnb, 32, lane);
        const float rdf = 1.0f / fmaxf(fabsf(sumf + inf_ * qnf), emf), rdb = 1.0f / fmaxf(fabsf(sumb + inb_ * qnb), emb);
        asm volatile("" ::: "memory");
#pragma unroll
        for (int st = 0; st < 8; ++st) {
            const f32x4 g4f = *(const f32x4*)(TOKV + (size_t)32 * SEQ + gf + 16 * st + 4 * fq), g4b = *(const f32x4*)(TOKV + (size_t)32 * SEQ + gb + 16 * st + 4 * fq);
            const int s0 = 16 * st + 4 * fq;
            f32x4 p;
            p.x = S[st].x * (((s0 + 0 <= t) ? __expf(x1f + g4f.x) * rdf : 0.f) + ((s0 + 0 >= t) ? __expf(x1b + g4b.x) * rdb : 0.f));
            p.y = S[st].y * (((s0 + 1 <= t) ? __expf(x1f + g4f.y) * rdf : 0.f) + ((s0 + 1 >= t) ? __expf(x1b + g4b.y) * rdb : 0.f));
            p.z = S[st].z * (((s0 + 2 <= t) ? __expf(x1f + g4f.z) * rdf : 0.f) + ((s0 + 2 >= t) ? __expf(x1b + g4b.z) * rdb : 0.f));
            p.w = S[st].w * (((s0 + 3 <= t) ? __expf(x1f + g4f.w) * rdf : 0.f) + ((s0 + 3 >= t) ? __expf(x1b + g4b.w) * rdb : 0.f));
            u32x2 w; w.x = cvt_pk_bf16(p.x, p.y); w.y = cvt_pk_bf16(p.z, p.w);
            *(LAS u32x2*)(PS + t * PITCH + (16 * st + 4 * fq) * 2) = w; }
        { const float sf = inf_ * rdf, sb = inb_ * rdb;
#pragma unroll
          for (int ks = 0; ks < 4; ++ks) {
              const float q0 = bf_lo(Qr[ks].x), q1 = bf_hi(Qr[ks].x), q2 = bf_lo(Qr[ks].y), q3 = bf_hi(Qr[ks].y), q4 = bf_lo(Qr[ks].z), q5 = bf_hi(Qr[ks].z), q6 = bf_lo(Qr[ks].w), q7 = bf_hi(Qr[ks].w);
              u32x4 w; w.x = cvt_pk_bf16(q0 * sf, q1 * sf); w.y = cvt_pk_bf16(q2 * sf, q3 * sf); w.z = cvt_pk_bf16(q4 * sf, q5 * sf); w.w = cvt_pk_bf16(q6 * sf, q7 * sf);
              *(LAS u32x4*)(QF + t * PITCH + (32 * ks + 8 * fq) * 2) = w;
              w.x = cvt_pk_bf16(q0 * sb, q1 * sb); w.y = cvt_pk_bf16(q2 * sb, q3 * sb); w.z = cvt_pk_bf16(q4 * sb, q5 * sb); w.w = cvt_pk_bf16(q6 * sb, q7 * sb);
              *(LAS u32x4*)(QBk + t * PITCH + (32 * ks + 8 * fq) * 2) = w; } }
#pragma unroll
        for (int vt = 0; vt < 2; ++vt) { const int vrow = 32 * wave + 16 * vt + fr;
#pragma unroll
            for (int ks = 0; ks < 4; ++ks) Cb[vt][ks] = *(const bf16x8*)(CST + (((size_t)(bh * 2 + 1) * NCH + oc) * DV + vrow) * DK + 32 * ks + 8 * fq); }
        __syncthreads();
        f32x4 acc[8][2];
#pragma unroll
        for (int tt = 0; tt < 8; ++tt) {
            acc[tt][0] = (f32x4){0.f, 0.f, 0.f, 0.f}; acc[tt][1] = acc[tt][0];
            const int ro = (16 * tt + fr) * PITCH + 16 * fq;
#pragma unroll
            for (int ks = 0; ks < 4; ++ks) { const bf16x8 p = *(const LAS bf16x8*)(PS + ro + 64 * ks);
                acc[tt][0] = __builtin_amdgcn_mfma_f32_16x16x32_bf16(Vf[0][ks], p, acc[tt][0], 0, 0, 0); acc[tt][1] = __builtin_amdgcn_mfma_f32_16x16x32_bf16(Vf[1][ks], p, acc[tt][1], 0, 0, 0); }
#pragma unroll
            for (int ks = 0; ks < 4; ++ks) { const bf16x8 p = *(const LAS bf16x8*)(QF + ro + 64 * ks);
                acc[tt][0] = __builtin_amdgcn_mfma_f32_16x16x32_bf16(Cf[0][ks], p, acc[tt][0], 0, 0, 0); acc[tt][1] = __builtin_amdgcn_mfma_f32_16x16x32_bf16(Cf[1][ks], p, acc[tt][1], 0, 0, 0); }
        }
#pragma unroll
        for (int tt = 0; tt < 8; ++tt) {
            const int ro = (16 * tt + fr) * PITCH + 16 * fq;
#pragma unroll
            for (int ks = 0; ks < 4; ++ks) { const bf16x8 p = *(const LAS bf16x8*)(QBk + ro + 64 * ks);
                acc[tt][0] = __builtin_amdgcn_mfma_f32_16x16x32_bf16(Cb[0][ks], p, acc[tt][0], 0, 0, 0); acc[tt][1] = __builtin_amdgcn_mfma_f32_16x16x32_bf16(Cb[1][ks], p, acc[tt][1], 0, 0, 0); }
            float ss = 0.f;
#pragma unroll
            for (int vt = 0; vt < 2; ++vt) ss += (acc[tt][vt].x * acc[tt][vt].x + acc[tt][vt].y * acc[tt][vt].y) + (acc[tt][vt].z * acc[tt][vt].z + acc[tt][vt].w * acc[tt][vt].w);
            ss += shx(ss, 16, lane); ss += shx(ss, 32, lane);
            if (fq == 0) RED[wave * 128 + 16 * tt + fr] = ss;
        }
        __syncthreads();
        { const int col0 = h * DV + 32 * wave + 4 * fq;
          const f32x4 hn0 = *(const f32x4*)(head_norm + col0), hn1 = *(const f32x4*)(head_norm + col0 + 16);
          size_t off = (T0 + fr) * 1024 + col0;
#pragma unroll
          for (int tt = 0; tt < 8; ++tt) {
            asm volatile("" : "+v"(off));
            float tot = 0.f;
#pragma unroll
            for (int w = 0; w < 8; ++w) tot += RED[w * 128 + 16 * tt + fr];
            const float rstd = rsqrtf(tot * (1.f / DV) + EPS);
#pragma unroll
            for (int vt = 0; vt < 2; ++vt) {
                const f32x4 hn = vt ? hn1 : hn0; const u32x2 so = *(const u32x2*)(SO + off + 16 * vt);
                const f32x4 a = acc[tt][vt]; u32x2 w;
                w.x = cvt_pk_bf16(a.x * rstd * hn.x * bf_lo(so.x), a.y * rstd * hn.y * bf_hi(so.x)); w.y = cvt_pk_bf16(a.z * rstd * hn.z * bf_lo(so.y), a.w * rstd * hn.w * bf_hi(so.y));
                *(u32x2*)(HM + off + 16 * vt) = w; }
            off += 16 * 1024;
          } }
        __syncthreads();
    }
}

__device__ __forceinline__ void gates_direct(const Frame& F, const float* bias) {
    const bf16_t* XB = (const bf16_t*)(F.ws + WS_XB); const bf16_t* WG = (const bf16_t*)(F.ws + WS_W) + WO_WIN + (size_t)1536 * DM;
    const float* SS = (const float*)(F.ws + WS_SS); float* GATES = (float*)(F.ws + WS_GATES);
    const int lane = F.lane, fr = lane & 15, fq = lane >> 4;
    for (int tile = F.bid * 8 + F.wave; tile < M / 16; tile += F.G * 8) {
        const bf16_t* ap = XB + (size_t)(tile * 16 + fr) * DM + 8 * fq; const bf16_t* bp = WG + (size_t)fr * DM + 8 * fq;
        f32x4 acc = {0.f, 0.f, 0.f, 0.f};
#pragma unroll 8
        for (int ks = 0; ks < 32; ++ks) { const bf16x8 a = *(const bf16x8*)(ap + 32 * ks), b = *(const bf16x8*)(bp + 32 * ks);
            acc = __builtin_amdgcn_mfma_f32_16x16x32_bf16(a, b, acc, 0, 0, 0); }
        const int row0 = tile * 16 + 4 * fq; const float bv = bias[fr];
        const f32x4 s4 = *(const f32x4*)(SS + row0);
        GATES[(size_t)(row0 + 0) * 16 + fr] = acc.x * rsqrtf(s4.x * (1.f / DM) + EPS) + bv; GATES[(size_t)(row0 + 1) * 16 + fr] = acc.y * rsqrtf(s4.y * (1.f / DM) + EPS) + bv;
        GATES[(size_t)(row0 + 2) * 16 + fr] = acc.z * rsqrtf(s4.z * (1.f / DM) + EPS) + bv; GATES[(size_t)(row0 + 3) * 16 + fr] = acc.w * rsqrtf(s4.w * (1.f / DM) + EPS) + bv;
    }
}

template <int HALF>
__device__ __forceinline__ void pool_item(const bf16_t* U, bf16_t* Y0, size_t row0, int bt0, int q, int g) {
    constexpr int NR = 2 * HALF + 3;
    f32x4 r[NR];
    u32x2 w_[NR];
#pragma unroll
    for (int i = 0; i < NR; ++i) { int tt = bt0 - HALF + i; tt = tt < 0 ? 0 : (tt > SEQ - 1 ? SEQ - 1 : tt);
        w_[i] = *((const u32x2*)(U + (row0 - bt0 + tt) * 1024) + q); }
#pragma unroll
    for (int i = 0; i < NR; ++i) { const int tt = bt0 - HALF + i; const float mk = (tt >= 0 && tt < SEQ) ? 1.f : 0.f;
        r[i] = (f32x4){bf_lo(w_[i].x) * mk, bf_hi(w_[i].x) * mk, bf_lo(w_[i].y) * mk, bf_hi(w_[i].y) * mk}; }
#pragma unroll
    for (int j = 0; j < 4; ++j) { const int t = bt0 + j; int lo = t - HALF; if (lo < 0) lo = 0; int hi = t + HALF; if (hi > SEQ) hi = SEQ;
        f32x4 sum = r[j];
#pragma unroll
        for (int i = 1; i < 2 * HALF; ++i) sum += r[j + i];
        const f32x4 y = sum * (1.0f / (float)(hi - lo)) - r[j + HALF];
        u32x2 w; w.x = cvt_pk_bf16(y.x, y.y); w.y = cvt_pk_bf16(y.z, y.w);
        *((u32x2*)(Y0 + ((size_t)g * M + row0 + j) * 256) + (q & 63)) = w; }
}
__device__ __forceinline__ void pool_phase(const Frame& F) {
    const bf16_t* U1 = (const bf16_t*)(F.ws + WS_U1); bf16_t* Y0 = (bf16_t*)(F.ws + WS_Y0);
    const int gt = F.bid * 512 + F.tid, NGT = F.G * 512;
    for (int it = gt; it < (M / 4) * 256; it += NGT) {
        const int q = it & 255, tb = it >> 8; const int g = q >> 6;
        const size_t row0 = (size_t)tb * 4; const int bt0 = (int)(row0 & (SEQ - 1));
        if (g == 0) pool_item<1>(U1, Y0, row0, bt0, q, g); else if (g == 1) pool_item<2>(U1, Y0, row0, bt0, q, g);
        else if (g == 2) pool_item<4>(U1, Y0, row0, bt0, q, g); else pool_item<8>(U1, Y0, row0, bt0, q, g);
    }
}

__device__ __forceinline__ void final_phase(const Frame& F, const float* gain, const float* ss, const bf16_t* hb) {
    const int gw = F.bid * 8 + F.wave, NGW = F.G * 8;
    const f32x4* gr = (const f32x4*)gain + F.lane;
    for (int m0 = gw * 4; m0 < M; m0 += NGW * 4) {
        u32x2 w[4][4]; float r[4];
#pragma unroll
        for (int q = 0; q < 4; ++q) { const u32x2* hr = (const u32x2*)(hb + (size_t)(m0 + q) * DM) + F.lane; r[q] = rsqrtf(ss[m0 + q] * (1.f / DM) + EPS);
#pragma unroll
            for (int j = 0; j < 4; ++j) w[q][j] = hr[64 * j]; }
#pragma unroll
        for (int q = 0; q < 4; ++q) { f32x4* xr = (f32x4*)(F.out + (size_t)(m0 + q) * DM) + F.lane;
#pragma unroll
            for (int j = 0; j < 4; ++j) { const f32x4 v = {bf_lo(w[q][j].x), bf_hi(w[q][j].x), bf_lo(w[q][j].y), bf_hi(w[q][j].y)}; xr[64 * j] = v * r[q] * gr[64 * j]; } }
    }
}

#define XB_TMO      128
#define XB_XCNT(j)  (256  + 64 * (j))
#define XB_XSUB(j)  (1280 + 64 * (j))
#define XB_XGEN(j)  (2304 + 64 * (j))
#define XB_TOP      3328
#define XB_TOPGEN   3392
#define XCD_BAR_WORDS 3456
#define XB_SPIN_CAP (1u << 22)
__device__ __forceinline__ unsigned xb_ld(unsigned* p)              { return __hip_atomic_load(p, __ATOMIC_RELAXED, __HIP_MEMORY_SCOPE_AGENT); }
__device__ __forceinline__ unsigned xb_add(unsigned* p, unsigned v) { return __hip_atomic_fetch_add(p, v, __ATOMIC_RELAXED, __HIP_MEMORY_SCOPE_AGENT); }
__device__ __forceinline__ unsigned xb_xcc_id() { return (unsigned)__builtin_amdgcn_s_getreg((3 << 11) | 20) & 0xFu; }
#define XB_SPIN(cond, bar) do { unsigned _sp = 0; while (cond) { __builtin_amdgcn_s_sleep(1); \
    if ((++_sp & 255u) == 0u) { if (xb_ld(&(bar)[XB_TMO])) break; if (_sp > XB_SPIN_CAP) { atomicAdd(&(bar)[XB_TMO], 1u); break; } } } } while (0)
__device__ __forceinline__ void xcd_barrier_complete(unsigned* bar, unsigned x, unsigned& nloc, unsigned& nx) {
    const unsigned G = gridDim.x;
    unsigned sum, cnt, mine, sp = 0u;
    for (;;) {
        sum = 0u; cnt = 0u; mine = 0u;
#pragma unroll
        for (unsigned j = 0; j < 16; ++j) { const unsigned c = xb_ld(&bar[XB_XCNT(j)]); sum += c; cnt += (c > 0u) ? 1u : 0u; mine = (j == x) ? c : mine; }
        if (sum == G) break;
        __builtin_amdgcn_s_sleep(1);
        if ((++sp & 255u) == 0u) { if (xb_ld(&bar[XB_TMO])) break; if (sp > XB_SPIN_CAP) { atomicAdd(&bar[XB_TMO], 1u); break; } }
    }
    nloc = mine > 0u ? mine : 1u; nx = cnt > 0u ? cnt : 1u;
}
__device__ __forceinline__ void xcd_barrier(unsigned* bar, volatile LAS unsigned* st, int tid) {
    asm volatile("s_waitcnt vmcnt(0)" ::: "memory");
    __syncthreads();
    if (tid == 0) {
        __builtin_amdgcn_s_waitcnt(0);
        const unsigned x = xb_xcc_id();
        unsigned nloc = st[0], nx = st[1];
        if (nloc == 0u) { xcd_barrier_complete(bar, x, nloc, nx); st[0] = nloc; st[1] = nx; }
        const unsigned old = xb_add(&bar[XB_XSUB(x)], 1u);
        const unsigned gen = old / nloc;
        if (old + 1u == (gen + 1u) * nloc) {
            __builtin_amdgcn_fence(__ATOMIC_RELEASE, "agent");
            asm volatile("s_waitcnt vmcnt(0)" ::: "memory");
            const unsigned og = xb_add(&bar[XB_TOP], 1u);
            const unsigned tg = og / nx;
            if (og + 1u == (tg + 1u) * nx) xb_add(&bar[XB_TOPGEN], 1u);
            else XB_SPIN(xb_ld(&bar[XB_TOPGEN]) == tg, bar);
            __builtin_amdgcn_fence(__ATOMIC_ACQUIRE, "agent");
            xb_add(&bar[XB_XGEN(x)], 1u);
            asm volatile("s_waitcnt vmcnt(0)" ::: "memory");
        } else {
            XB_SPIN(xb_ld(&bar[XB_XGEN(x)]) == gen, bar);
            __builtin_amdgcn_fence(__ATOMIC_ACQUIRE, "agent");
            asm volatile("s_waitcnt vmcnt(0)" ::: "memory");
        }
    }
    __syncthreads();
}

constexpr int N_PHASES = 15;
typedef const __attribute__((address_space(4))) Args* KArgP;
__device__ __forceinline__ Args load_args_() {
    Args a{};
#if defined(__HIP_DEVICE_COMPILE__)
    KArgP p_ = (KArgP)__builtin_amdgcn_kernarg_segment_ptr(); asm volatile("" : "+s"(p_));
#pragma unroll
    for (int i = 0; i < 19; ++i) a.in[i] = p_->in[i];
    a.out = p_->out; a.ws = p_->ws; a.ph_lo = p_->ph_lo; a.ph_hi = p_->ph_hi;
#endif
    return a;
}
#define LOADARGS() load_args_()
#define MKFRAME(A) Frame F; F.lds = (LAS unsigned char*)lds_raw; { int l_ = lane_id_fresh(); F.lane = l_; int b_ = blockIdx.x; asm volatile("" : "+s"(b_)); F.bid = b_; } F.wave = wvid; F.tid = wvid * 64 + F.lane; F.G = gridDim.x; F.ws = (A).ws; F.out = (A).out; \
    unsigned char* ws = (A).ws; bf16_t* WB = (bf16_t*)(ws + WS_W); float* SS = (float*)(ws + WS_SS); bf16_t* XB = (bf16_t*)(ws + WS_XB); bf16_t* XB2 = (bf16_t*)(ws + WS_Y1); bf16_t* HMb = (bf16_t*)(ws + WS_HM); bf16_t* PB = (bf16_t*)(ws + WS_PB); bf16_t* ACT = (bf16_t*)(ws + WS_ACT); \
    (void)WB; (void)SS; (void)XB; (void)XB2; (void)HMb; (void)PB; (void)ACT;
__global__ void __launch_bounds__(512, 2) mk_fwd(Args args) {
    extern __shared__ __attribute__((aligned(16))) unsigned char lds_raw[];
    const int lo = args.ph_lo, hi = args.ph_hi;
#define LCTL ((volatile LAS unsigned*)((LAS unsigned char*)lds_raw + (LDS_BYTES - 64)))
    if (threadIdx.x == 0) { LCTL[0] = 0u; LCTL[1] = 0u; LCTL[2] = 0u; }
    __syncthreads();
    int wvid;
    { const int l0 = lane_id_fresh(); unsigned w = 0u;
      if (l0 == 0) w = __hip_atomic_fetch_add((LAS unsigned*)((LAS unsigned char*)lds_raw + (LDS_BYTES - 64)), 1u, __ATOMIC_RELAXED, __HIP_MEMORY_SCOPE_WORKGROUP);
      wvid = __builtin_amdgcn_readfirstlane((int)w);
      if (MK_MULTI == 0 && wvid == 0 && l0 == 0) (void)xb_add((unsigned*)args.ws + XB_XCNT(xb_xcc_id()), 1u); }
#ifndef PH_MASK
#define PH_MASK 0xFFFF
#endif
#define IN(k) ((((PH_MASK) >> (k)) & 1) && lo <= (k) && (k) < hi)
#define SEAM(k) do { if (lo <= (k) && (k) + 1 < hi) { if ((k) == 0) cg::this_grid().sync(); else { const Args A_ = LOADARGS(); int l_ = lane_id_fresh(); xcd_barrier((unsigned*)A_.ws, LCTL + 1, wvid * 64 + l_); } } } while (0)

    if (IN(0)) { const Args A = LOADARGS(); MKFRAME(A); p0_prologue(F, A); }
    SEAM(0);
    if (IN(1)) {
        const Args A = LOADARGS(); MKFRAME(A);
        gates_direct(F, A.in[7]);
        { pg8::Gemm g{XB, WB + WO_WIN, M, 1536, DM, 0}; pg8::StaticOrder S; S.init(M, 1536, F.G, F.bid);
          Epi<EP_QO> E; E.a = EpiArgs{}; E.a.ss_in = SS; E.a.qb = (bf16_t*)(ws + WS_QB); E.a.so = (bf16_t*)(ws + WS_SO); E.a.gates = (float*)(ws + WS_GATES); E.a.bias = A.in[7];
          pg8::gemm_phase(F.lds, g, S, E, wvid * 64 + lane_id_fresh()); }
        { pg8::Gemm g{XB, WB + WO_WIN + (size_t)NA * DM, M, NBK, DM, 0}; pg8::StaticOrder S; S.init(M, NBK, F.G, F.bid);
          Epi<EP_KV> E; E.a = EpiArgs{}; E.a.ss_in = SS; E.a.kb = (bf16_t*)(ws + WS_KB); E.a.kt = (bf16_t*)(ws + WS_KT); E.a.vt = (bf16_t*)(ws + WS_VT);
          pg8::gemm_phase(F.lds, g, S, E, wvid * 64 + lane_id_fresh()); }
    }
    SEAM(1);
    if (IN(2)) { const Args A = LOADARGS(); MKFRAME(A); mlstm_scan(F, A.out); }
    SEAM(2);
    if (IN(3)) { const Args A = LOADARGS(); MKFRAME(A); mlstm_out(F, A.in[8], A.out); }
    SEAM(3);
    if (IN(4)) {
        const Args A = LOADARGS(); MKFRAME(A);
        pg8::Gemm g{HMb, WB + WO_WOUT, M, DM, DM, 0}; pg8::StaticOrder S; S.init(M, DM, F.G, F.bid);
        Epi<EP_RES32> E; E.a = EpiArgs{}; E.a.res32 = A.in[0]; E.a.xbo = XB; E.a.ss_out = SS + 1 * M;
        pg8::gemm_phase(F.lds, g, S, E, F.tid);
    }
    SEAM(4);
#pragma unroll
    for (int l = 0; l < 2; ++l) {
        const int pb = 5 + 7 * l;
        if (l == 1) {
            if (IN(8)) {
                const Args A = LOADARGS(); MKFRAME(A);
                pg8::Gemm g{XB2, WB + WO_PIN, M, DM, DM, 0}; pg8::StaticOrder S; S.init(M, DM, F.G, F.bid);
                Epi<EP_BF16S> E; E.a = EpiArgs{}; E.a.ss_in = SS + 3 * M; E.a.o16 = (bf16_t*)(ws + WS_U1); E.a.ldc = DM;
                pg8::gemm_phase(F.lds, g, S, E, F.tid);
            }
            SEAM(8);
            if (IN(9)) { const Args A = LOADARGS(); MKFRAME(A); pool_phase(F); }
            SEAM(9);
            if (IN(10)) {
                const Args A = LOADARGS(); MKFRAME(A);
                pg8::Gemm g{(const bf16_t*)(ws + WS_Y0), WB + WO_GRP, M, DM, 256, (size_t)M * 256}; pg8::StaticOrder S; S.init(M, DM, F.G, F.bid);
                Epi<EP_BF16> E; E.a = EpiArgs{}; E.a.o16 = HMb; E.a.ldc = DM;
                pg8::gemm_phase(F.lds, g, S, E, F.tid);
            }
            SEAM(10);
            if (IN(11)) {
                const Args A = LOADARGS(); MKFRAME(A);
                pg8::Gemm g{HMb, WB + WO_POUT, M, DM, DM, 0}; pg8::StaticOrder S; S.init(M, DM, F.G, F.bid);
                Epi<EP_RES> E; E.a = EpiArgs{}; E.a.res16 = XB2; E.a.xbo = XB; E.a.ss_out = SS + 4 * M;
                pg8::gemm_phase(F.lds, g, S, E, F.tid);
            }
            SEAM(11);
        }
        const int si = 1 + 3 * l;
        if (IN(pb)) {
            const Args A = LOADARGS(); MKFRAME(A);
            { pg8::Gemm g{XB, WB + WO_W1 + (size_t)l * FF * DM, M, FF, DM, 0}; pg8::StaticOrder S; S.init(M, FF, F.G, F.bid);
              Epi<EP_SQRELU> E; E.a = EpiArgs{}; E.a.ss_in = SS + si * M; E.a.o16 = ACT; E.a.ldc = FF;
              pg8::gemm_phase(F.lds, g, S, E, F.tid); }
            { pg8::Gemm g{PB + (size_t)l * M * PLE, WB + WO_PLE + (size_t)l * DM * PLE, M, DM, PLE, 0}; pg8::StaticOrder S; S.init(M, DM, F.G, F.bid);
              Epi<EP_BF16> E; E.a = EpiArgs{}; E.a.o16 = HMb; E.a.ldc = DM;
              pg8::gemm_phase(F.lds, g, S, E, wvid * 64 + lane_id_fresh()); }
        }
        SEAM(pb);
        if (IN(pb + 1)) {
            const Args A = LOADARGS(); MKFRAME(A);
            pg8::Gemm g{ACT, WB + WO_W2 + (size_t)l * FF * DM, M, DM, FF, 0}; pg8::StaticOrder S; S.init(M, DM, F.G, F.bid);
            Epi<EP_RES> E; E.a = EpiArgs{}; E.a.res16 = XB; E.a.xbo = XB; E.a.ss_out = SS + (si + 1) * M;
            pg8::gemm_phase(F.lds, g, S, E, F.tid);
        }
        SEAM(pb + 1);
        if (IN(pb + 2)) {
            const Args A = LOADARGS(); MKFRAME(A);
            pg8::Gemm g{XB, WB + WO_GATE + (size_t)l * DM * DM, M, DM, DM, 0}; pg8::StaticOrder S; S.init(M, DM, F.G, F.bid);
            Epi<EP_GATE> E; E.a = EpiArgs{}; E.a.ss_in = SS + (si + 1) * M; E.a.res16 = XB; E.a.xbo = XB2; E.a.ss_out = SS + (si + 2) * M;
            E.a.bias = A.in[18] + l * DM; E.a.pe = HMb;
            pg8::gemm_phase(F.lds, g, S, E, F.tid);
        }
        SEAM(pb + 2);
    }
    if (IN(15)) { const Args A = LOADARGS(); MKFRAME(A); final_phase(F, A.in[5], SS + 6 * M, XB2); }
#undef IN
#undef SEAM
}

extern "C" void kernel_launch(void* const* d_in, const int* in_sizes, int n_in, void* d_out, int out_size, void* d_ws, size_t ws_size, hipStream_t stream) {
    static int grid = 0;
    if (grid == 0) {
        if (n_in != 19 || out_size != M * DM || ws_size < WS_END) { fprintf(stderr, "kernel_launch: unexpected shapes (n_in %d out %d ws %zu)\n", n_in, out_size, ws_size); grid = -1; return; }
        int dev = 0, cus = 0, per_cu = 0;
        hipGetDevice(&dev); hipDeviceGetAttribute(&cus, hipDeviceAttributeMultiprocessorCount, dev);
        hipFuncSetAttribute((const void*)mk_fwd, hipFuncAttributeMaxDynamicSharedMemorySize, LDS_BYTES);
        if (hipOccupancyMaxActiveBlocksPerMultiprocessor(&per_cu, (const void*)mk_fwd, 512, LDS_BYTES) != hipSuccess || per_cu < 1) { fprintf(stderr, "kernel_launch: occupancy query gave %d\n", per_cu); per_cu = 1; }
        (void)hipGetLastError();
        grid = cus * per_cu;
        fprintf(stderr, "kernel_launch: grid %d (cus %d per_cu %d)\n", grid, cus, per_cu);
    }
    if (grid < 0) return;
    Args a{};
    for (int i = 0; i < 19; ++i) a.in[i] = (const float*)d_in[i];
    a.out = (float*)d_out; a.ws = (unsigned char*)d_ws;
    hipMemsetAsync(d_ws, 0, 16384, stream);
#if MK_MULTI
    for (int ph = 0; ph <= N_PHASES; ++ph) { a.ph_lo = ph; a.ph_hi = ph + 1; hipLaunchKernelGGL(mk_fwd, dim3(grid), dim3(512), LDS_BYTES, stream, a); }
#else
    a.ph_lo = 0; a.ph_hi = N_PHASES + 1;
    void* kargs[] = {&a};
    hipError_t e = hipLaunchCooperativeKernel((const void*)mk_fwd, dim3(grid), dim3(512), kargs, LDS_BYTES, stream);
    if (e != hipSuccess) fprintf(stderr, "cooperative launch failed: %s (grid %d)\n", hipGetErrorString(e), grid);
#ifdef PROBE_LIST
    { const int pl[] = {PROBE_LIST}; for (int ph : pl) { Args b = a; b.out = (float*)((unsigned char*)d_ws + WS_U1); b.ph_lo = ph; b.ph_hi = ph + 1; hipLaunchKernelGGL(mk_fwd, dim3(grid), dim3(512), LDS_BYTES, stream, b); } }
#endif
#endif
}
```

```cpp
#include <hip/hip_runtime.h>
#include <hip/hip_cooperative_groups.h>
#include <cstdio>
#include <cstdint>
namespace cg = cooperative_groups;

#ifndef MK_MULTI
#define MK_MULTI 0
#endif

#define LAS __attribute__((address_space(3)))
typedef unsigned short bf16_t;
typedef short bf16x8 __attribute__((ext_vector_type(8)));
typedef float f32x4 __attribute__((ext_vector_type(4)));
typedef float f32x2 __attribute__((ext_vector_type(2)));
typedef unsigned u32x4 __attribute__((ext_vector_type(4)));
typedef unsigned u32x2 __attribute__((ext_vector_type(2)));

constexpr int DM = 1024, NB = 4, SEQ = 8192, M = NB * SEQ, FF = 4096, PLE = 256;
constexpr int NH = 4, DK = 128, DV = 256, LCH = 128, NCH = SEQ / LCH;
constexpr int WIN_N = 3088;
constexpr int NA = 1792, NBK = 1536;
constexpr float EPS = 1e-6f;

constexpr size_t MiB = 1u << 20;
constexpr size_t WS_GATES = 1 * MiB;
constexpr size_t WS_SS = 3 * MiB;
constexpr size_t WS_NST = 4 * MiB;
constexpr size_t WS_TOKV = 5 * MiB;
constexpr size_t WS_W = 10 * MiB;
constexpr size_t WS_XB = 64 * MiB;
constexpr size_t WS_PB = 128 * MiB;
constexpr size_t WS_HM = 160 * MiB;
constexpr size_t WS_U = 224 * MiB;
constexpr size_t WS_QB = WS_U, WS_KB = WS_U + 32 * MiB, WS_KT = WS_U + 64 * MiB, WS_VT = WS_U + 96 * MiB, WS_SO = WS_U + 160 * MiB;
constexpr size_t WS_ACT = 224 * MiB;
constexpr size_t WS_U1 = 224 * MiB;
constexpr size_t WS_Y0 = 352 * MiB;
constexpr size_t WS_Y1 = 416 * MiB;
constexpr size_t WS_END = 480 * MiB;
constexpr size_t WO_WIN = 0;
constexpr size_t WO_WOUT = WO_WIN + (size_t)3328 * 1024;
constexpr size_t WO_PIN = WO_WOUT + (size_t)1024 * 1024;
constexpr size_t WO_GRP = WO_PIN + (size_t)1024 * 1024;
constexpr size_t WO_POUT = WO_GRP + (size_t)1024 * 256;
constexpr size_t WO_W1 = WO_POUT + (size_t)1024 * 1024;
constexpr size_t WO_W2 = WO_W1 + (size_t)2 * 4096 * 1024;
constexpr size_t WO_PLE = WO_W2 + (size_t)2 * 4096 * 1024;
constexpr size_t WO_GATE = WO_PLE + (size_t)2 * 1024 * 256;
constexpr size_t WO_END = WO_GATE + (size_t)2 * 1024 * 1024;
static_assert(WS_W + WO_END * 2 <= WS_XB, "weights fit");

constexpr int LDS_BYTES = 147456;

__device__ __forceinline__ unsigned cvt_pk_bf16(float lo, float hi) { unsigned r; asm volatile("v_cvt_pk_bf16_f32 %0, %1, %2" : "=v"(r) : "v"(lo), "v"(hi)); return r; }
__device__ __forceinline__ float bf_lo(unsigned w) { return __uint_as_float(w << 16); }
__device__ __forceinline__ float bf_hi(unsigned w) { return __uint_as_float(w & 0xffff0000u); }
__device__ __forceinline__ float sigmoidf_(float v) { return 1.0f / (1.0f + __expf(-v)); }

__device__ __forceinline__ float shx(float v, int mask, int lane) { return __int_as_float(__builtin_amdgcn_ds_bpermute((lane ^ mask) << 2, __float_as_int(v))); }
__device__ __forceinline__ float shup(float v, int d, int lane) { return __int_as_float(__builtin_amdgcn_ds_bpermute((lane - d) << 2, __float_as_int(v))); }
__device__ __forceinline__ int lane_id_fresh() { unsigned m = ~0u; asm volatile("" : "+s"(m)); return (int)__builtin_amdgcn_mbcnt_hi(m, __builtin_amdgcn_mbcnt_lo(m, 0u)); }
namespace pg8 {
constexpr int BM = 256, BK = 64, HALF = 128, HTB = HALF * BK * 2, STAGE_BYTES = 8 * HTB, NXCD = 8, WGM = 8;
__host__ __device__ __forceinline__ int lds_byte(int r, int c) { const int st = (r >> 4) * 2 + (c >> 5), rr = r & 15, cc = c & 31, ob = rr * 64 + cc * 2; return st * 1024 + (ob ^ (((ob >> 9) & 1) << 5)); }
__host__ __device__ __forceinline__ void stage_rc(int b, int& R, int& C) { const int st = b / 1024, sb = b % 1024, swz = sb ^ (((sb >> 9) & 1) << 5); R = (st >> 1) * 16 + swz / 64; C = (st & 1) * 32 + (swz % 64) / 2; }
__host__ __device__ __forceinline__ int perm32(int rho) { const int n = rho >> 4, i = rho & 15; return 8 * (i >> 2) + 4 * n + (i & 3); }

struct Unit { int pm, pn; };
struct Gemm { const bf16_t* A; const bf16_t* Bt; int M, N, K; size_t acol; };

struct StaticOrder {
    int nM, nN, nwg, G, c;
    __device__ void init(int M_, int N_, int G_, int c_) { nM = M_ / BM; nN = N_ / BM; nwg = nM * nN; G = G_; c = c_; }
    __device__ bool next(int i, Unit& u) const {
        const long L = (long)i * G + c; if (L >= nwg) return false;
        int wgid = (int)L; { const int q = nwg / NXCD, r = nwg % NXCD, xcd = wgid % NXCD, off = wgid / NXCD; wgid = (xcd < r ? xcd * (q + 1) : r * (q + 1) + (xcd - r) * q) + off; }
        const int nig = WGM * nN, gid = wgid / nig, fm = gid * WGM, gsz = (nM - fm) < WGM ? (nM - fm) : WGM;
        u.pm = fm + ((wgid % nig) % gsz); u.pn = (wgid % nig) / gsz; return true;
    }
};

template <class Epi>
__device__ __forceinline__ void gemm_phase(LAS unsigned char* lds, const Gemm g, const StaticOrder& S, const Epi& E, int tid_in) {
    int tid_ = tid_in; asm volatile("" : "+v"(tid_));
    const int tid = tid_, wid = __builtin_amdgcn_readfirstlane(tid >> 6), lane = tid & 63, wr = wid >> 2, wc = wid & 3, fr = lane & 15, fq = lane >> 4;
    const int K = g.K, nt = K / BK;
    unsigned voffA[2], voffB[2];
#pragma unroll
    for (int i = 0; i < 2; ++i) { int R, C; stage_rc(tid * 16 + i * 8192, R, C); const int Rb = Epi::PERM ? ((R & ~31) + perm32(R & 31)) : R;
        voffA[i] = (unsigned)(R * K + C) * 2u; voffB[i] = (unsigned)(Rb * K + C) * 2u; }
    const size_t kstep = (size_t)(BK * 2);
    const size_t hstep = (size_t)HALF * K * 2;
    const size_t tstep = 2 * hstep;
    const unsigned ldsw = (unsigned)wid * 1024u;
    const int aoff = lds_byte(wr * 64 + fr, fq * 8), boff = lds_byte(wc * 32 + fr, fq * 8);
#define PG8_SA(b, h) (((b) * 2 + (h)) * HTB)
#define PG8_SB(b, h) ((4 + (b) * 2 + (h)) * HTB)
#define PG8_STAGE(bufoff, gbase, voff) do { const char* gb_ = (const char*)(gbase); asm volatile("" : "+s"(gb_));   \
        _Pragma("unroll") for (int _i = 0; _i < 2; ++_i) \
        __builtin_amdgcn_global_load_lds((const unsigned*)(gb_ + (voff)[_i]), (LAS unsigned*)(lds + (bufoff) + ldsw + _i * 8192), 16, 0, 0); } while (0)
#define PG8_LDA(dst, b, h) do { _Pragma("unroll") for (int m = 0; m < 4; ++m) _Pragma("unroll") for (int k = 0; k < 2; ++k) dst[m][k] = *(const LAS bf16x8*)(lds + PG8_SA(b, h) + aoff + m * 2048 + k * 1024); } while (0)
#define PG8_LDB(dst, b, h) do { _Pragma("unroll") for (int n = 0; n < 2; ++n) _Pragma("unroll") for (int k = 0; k < 2; ++k) dst[n][k] = *(const LAS bf16x8*)(lds + PG8_SB(b, h) + boff + n * 2048 + k * 1024); } while (0)
#define PG8_MMA(ai, bj, At, Bt) do { __builtin_amdgcn_s_setprio(1); _Pragma("unroll") for (int m = 0; m < 4; ++m) _Pragma("unroll") for (int n = 0; n < 2; ++n) _Pragma("unroll") for (int k = 0; k < 2; ++k) \
        acc[ai][bj][m][n] = Epi::SWAP ? __builtin_amdgcn_mfma_f32_16x16x32_bf16(At[m][k], Bt[n][k], acc[ai][bj][m][n], 0, 0, 0) \
                                      : __builtin_amdgcn_mfma_f32_16x16x32_bf16(Bt[n][k], At[m][k], acc[ai][bj][m][n], 0, 0, 0); __builtin_amdgcn_s_setprio(0); } while (0)
#define PG8_WAIT_V(n) asm volatile("s_waitcnt vmcnt(" #n ")" ::: "memory")
#define PG8_WAIT_L(n) asm volatile("s_waitcnt lgkmcnt(" #n ")" ::: "memory")
#define PG8_BAR __builtin_amdgcn_s_barrier()
#define PG8_SCHED __builtin_amdgcn_sched_barrier(0)
    Unit cur, nxt; int ui = 0;
    if (!S.next(0, cur)) return;
    f32x4 acc[2][2][4][2];
#pragma unroll
    for (int a = 0; a < 2; ++a)
#pragma unroll
        for (int b = 0; b < 2; ++b)
#pragma unroll
            for (int m = 0; m < 4; ++m)
#pragma unroll
                for (int n = 0; n < 2; ++n) acc[a][b][m][n] = (f32x4){0.f, 0.f, 0.f, 0.f};
    bf16x8 At[4][2], B0[2][2], B1[2][2];
    const char* cA = (const char*)g.A + (size_t)cur.pm * tstep + (size_t)cur.pn * g.acol * 2; const char* cB = (const char*)g.Bt + (size_t)cur.pn * tstep;
    PG8_STAGE(PG8_SB(0, 0), cB, voffB); PG8_STAGE(PG8_SB(0, 1), cB + hstep, voffB); PG8_STAGE(PG8_SA(0, 0), cA, voffA); PG8_STAGE(PG8_SA(0, 1), cA + hstep, voffA);
    if (wr == 1) PG8_BAR;
    PG8_WAIT_V(2); PG8_BAR;
    PG8_STAGE(PG8_SB(1, 0), cB + kstep, voffB); PG8_STAGE(PG8_SA(1, 0), cA + kstep, voffA); PG8_STAGE(PG8_SB(1, 1), cB + hstep + kstep, voffB);
    PG8_WAIT_V(6); PG8_BAR;
    for (;;) {
        const bool has_next = S.next(ui + 1, nxt);
        const char* nA = has_next ? (const char*)g.A + (size_t)nxt.pm * tstep + (size_t)nxt.pn * g.acol * 2 : cA; const char* nB = has_next ? (const char*)g.Bt + (size_t)nxt.pn * tstep : cB;
        for (int t = 0; t < nt; t += 2) {
            const bool last = (t == nt - 2);
            const char* a1 = cA + (size_t)(t + 1) * kstep;
            const char* a2 = last ? nA : cA + (size_t)(t + 2) * kstep; const char* b2 = last ? nB : cB + (size_t)(t + 2) * kstep;
            const char* a3 = a2 + kstep; const char* b3 = b2 + kstep;
            PG8_LDB(B0, 0, 0); PG8_LDB(B1, 0, 1); PG8_SCHED; PG8_LDA(At, 0, 0); PG8_STAGE(PG8_SA(1, 1), a1 + hstep, voffA);
            PG8_WAIT_V(8); PG8_WAIT_L(0); PG8_BAR; PG8_MMA(0, 0, At, B0); PG8_MMA(0, 1, At, B1); PG8_BAR; PG8_SCHED;
            PG8_LDA(At, 0, 1); PG8_STAGE(PG8_SB(0, 0), b2, voffB); PG8_STAGE(PG8_SB(0, 1), b2 + hstep, voffB); PG8_STAGE(PG8_SA(0, 0), a2, voffA);
            PG8_WAIT_V(8); PG8_WAIT_L(0); PG8_BAR; PG8_MMA(1, 0, At, B0); PG8_MMA(1, 1, At, B1); PG8_BAR; PG8_SCHED;
            PG8_LDB(B0, 1, 0); PG8_LDB(B1, 1, 1); PG8_SCHED; PG8_LDA(At, 1, 0); PG8_STAGE(PG8_SA(0, 1), a2 + hstep, voffA);
            PG8_WAIT_V(8); PG8_WAIT_L(0); PG8_BAR; PG8_MMA(0, 0, At, B0); PG8_MMA(0, 1, At, B1); PG8_BAR; PG8_SCHED;
            PG8_LDA(At, 1, 1); PG8_STAGE(PG8_SB(1, 0), b3, voffB); PG8_STAGE(PG8_SB(1, 1), b3 + hstep, voffB); PG8_STAGE(PG8_SA(1, 0), a3, voffA);
            PG8_WAIT_V(8); PG8_WAIT_L(0); PG8_BAR; PG8_MMA(1, 0, At, B0); PG8_MMA(1, 1, At, B1); PG8_BAR; PG8_SCHED;
        }
        if (wr == 0) PG8_BAR;
        const int lane2 = lane_id_fresh();
        E(acc, cur, wr, wc, lane2 & 15, lane2 >> 4);
        if (!has_next) break;
        { int t2 = wid * 64 + lane_id_fresh();
#pragma unroll
          for (int i = 0; i < 2; ++i) { int R, C; stage_rc(t2 * 16 + i * 8192, R, C); const int Rb = Epi::PERM ? ((R & ~31) + perm32(R & 31)) : R;
              voffA[i] = (unsigned)(R * K + C) * 2u; voffB[i] = (unsigned)(Rb * K + C) * 2u; } }
#pragma unroll
        for (int a = 0; a < 2; ++a)
#pragma unroll
            for (int b = 0; b < 2; ++b)
#pragma unroll
                for (int m = 0; m < 4; ++m)
#pragma unroll
                    for (int n = 0; n < 2; ++n) acc[a][b][m][n] = (f32x4){0.f, 0.f, 0.f, 0.f};
        cur = nxt; cA = nA; cB = nB; ++ui;
        if (wr == 1) PG8_BAR;
    }
    PG8_WAIT_V(0);
    PG8_BAR;
#undef PG8_SA
#undef PG8_SB
#undef PG8_STAGE
#undef PG8_LDA
#undef PG8_LDB
#undef PG8_MMA
#undef PG8_WAIT_V
#undef PG8_WAIT_L
#undef PG8_BAR
#undef PG8_SCHED
}
}

enum { EP_QO = 0, EP_KV, EP_RES, EP_GATE, EP_SQRELU, EP_BF16, EP_F32SCALE, EP_RES32, EP_BF16S };
struct EpiArgs {
    const float* ss_in;
    const float* res32;
    const bf16_t* res16;
    bf16_t* xbo;
    float* ss_out;
    const float* bias;
    const bf16_t* pe;
    bf16_t* o16; int ldc;
    float* o32;
    bf16_t *qb, *kb, *kt, *vt, *so; float* gates;
};
template <int MODE> struct Epi {
    static constexpr bool PERM = (MODE != EP_KV), SWAP = (MODE == EP_KV);
    EpiArgs a;
    __device__ __forceinline__ void operator()(const f32x4 (&acc)[2][2][4][2], const pg8::Unit& u, int wr, int wc, int fr_, int fq_) const {
        int fr = fr_, fq = fq_; asm volatile("" : "+v"(fr), "+v"(fq));
        if constexpr (MODE == EP_KV) {
#pragma unroll
            for (int ai = 0; ai < 2; ++ai)
#pragma unroll
                for (int m = 0; m < 4; ++m) {
                    const int row0 = u.pm * 256 + ai * 128 + wr * 64 + m * 16 + 4 * fq;
                    const f32x4 s4 = *(const f32x4*)(a.ss_in + row0);
                    f32x4 r4; r4.x = rsqrtf(s4.x * (1.f / DM) + EPS); r4.y = rsqrtf(s4.y * (1.f / DM) + EPS); r4.z = rsqrtf(s4.z * (1.f / DM) + EPS); r4.w = rsqrtf(s4.w * (1.f / DM) + EPS);
                    const int b = row0 >> 13, tok = row0 & 8191;
#pragma unroll
                    for (int bj = 0; bj < 2; ++bj)
#pragma unroll
                        for (int n = 0; n < 2; ++n) {
                            const int col = u.pn * 256 + bj * 128 + wc * 32 + 16 * n + fr;
                            const f32x4 v = acc[ai][bj][m][n] * r4;
                            u32x2 w; w.x = cvt_pk_bf16(v.x, v.y); w.y = cvt_pk_bf16(v.z, v.w);
                            if (u.pn < 2) {
                                const int hd = col >> 7, dk = col & 127;
                                *(u32x2*)(a.kt + ((size_t)((b * NH + hd) * DK + dk)) * SEQ + tok) = w;
                                bf16_t* kr = a.kb + (size_t)row0 * 512 + col;
                                kr[0] = (bf16_t)(w.x & 0xffff); kr[512] = (bf16_t)(w.x >> 16); kr[1024] = (bf16_t)(w.y & 0xffff); kr[1536] = (bf16_t)(w.y >> 16);
                            } else {
                                const int vc = col - 512, hd = vc >> 8, dv = vc & 255;
                                *(u32x2*)(a.vt + ((size_t)((b * NH + hd) * DV + dv)) * SEQ + tok) = w;
                            }
                        }
                }
        } else {
            const int rowb = u.pm * 256 + wr * 64 + fr, colb = u.pn * 256 + wc * 32 + 8 * fq;
            constexpr bool USE_SS = (MODE == EP_QO || MODE == EP_GATE || MODE == EP_SQRELU || MODE == EP_F32SCALE || MODE == EP_BF16S);
            constexpr bool IS_RES = (MODE == EP_RES || MODE == EP_RES32 || MODE == EP_GATE);
            constexpr int MB = (MODE == EP_RES32 || MODE == EP_GATE) ? 2 : 4;
            f32x4 gb[2][2];
            if constexpr (MODE == EP_GATE) {
#pragma unroll
                for (int bj = 0; bj < 2; ++bj) { gb[bj][0] = *(const f32x4*)(a.bias + colb + bj * 128); gb[bj][1] = *(const f32x4*)(a.bias + colb + bj * 128 + 4); } }
#pragma unroll
            for (int ai = 0; ai < 2; ++ai)
#pragma unroll
              for (int mb = 0; mb < 4; mb += MB) {
                float ssv[MB]; u32x4 rw[MB][2]; f32x4 r32[MB][2][2]; u32x4 pwv[MB][2];
#pragma unroll
                for (int mm = 0; mm < MB; ++mm) { const int row = rowb + ai * 128 + (mb + mm) * 16;
                    if constexpr (USE_SS) ssv[mm] = a.ss_in[row];
#pragma unroll
                    for (int bj = 0; bj < 2; ++bj) { const size_t off = (size_t)row * DM + colb + bj * 128;
                        if constexpr (MODE == EP_RES32) { r32[mm][bj][0] = *(const f32x4*)(a.res32 + off); r32[mm][bj][1] = *(const f32x4*)(a.res32 + off + 4); }
                        if constexpr (MODE == EP_RES || MODE == EP_GATE) rw[mm][bj] = *(const u32x4*)(a.res16 + off);
                        if constexpr (MODE == EP_GATE) pwv[mm][bj] = *(const u32x4*)(a.pe + off); } }
#pragma unroll
                for (int mm = 0; mm < MB; ++mm) {
                    const int m = mb + mm;
                    const int row = rowb + ai * 128 + m * 16;
                    float rs = 1.f;
                    if constexpr (USE_SS) rs = rsqrtf(ssv[mm] * (1.f / DM) + EPS);
                    float ssq = 0.f;
#pragma unroll
                    for (int bj = 0; bj < 2; ++bj) {
                        const int col = colb + bj * 128;
                        f32x4 v0 = acc[ai][bj][m][0] * rs, v1 = acc[ai][bj][m][1] * rs;
                        if constexpr (MODE == EP_QO) {
                            if (u.pn < 2) {
                                u32x4 w; w.x = cvt_pk_bf16(v0.x, v0.y); w.y = cvt_pk_bf16(v0.z, v0.w); w.z = cvt_pk_bf16(v1.x, v1.y); w.w = cvt_pk_bf16(v1.z, v1.w);
                                *(u32x4*)(a.qb + (size_t)row * 512 + col) = w;
                            } else if (u.pn < 6) {
                                u32x4 w; w.x = cvt_pk_bf16(sigmoidf_(v0.x), sigmoidf_(v0.y)); w.y = cvt_pk_bf16(sigmoidf_(v0.z), sigmoidf_(v0.w));
                                w.z = cvt_pk_bf16(sigmoidf_(v1.x), sigmoidf_(v1.y)); w.w = cvt_pk_bf16(sigmoidf_(v1.z), sigmoidf_(v1.w));
                                *(u32x4*)(a.so + (size_t)row * 1024 + (col - 512)) = w;
                            }
                        } else if constexpr (MODE == EP_SQRELU) {
                            v0.x = fmaxf(v0.x, 0.f); v0.y = fmaxf(v0.y, 0.f); v0.z = fmaxf(v0.z, 0.f); v0.w = fmaxf(v0.w, 0.f);
                            v1.x = fmaxf(v1.x, 0.f); v1.y = fmaxf(v1.y, 0.f); v1.z = fmaxf(v1.z, 0.f); v1.w = fmaxf(v1.w, 0.f);
                            v0 = v0 * v0; v1 = v1 * v1;
                            u32x4 w; w.x = cvt_pk_bf16(v0.x, v0.y); w.y = cvt_pk_bf16(v0.z, v0.w); w.z = cvt_pk_bf16(v1.x, v1.y); w.w = cvt_pk_bf16(v1.z, v1.w);
                            *(u32x4*)(a.o16 + (size_t)row * a.ldc + col) = w;
                        } else if constexpr (MODE == EP_BF16 || MODE == EP_BF16S) {
                            u32x4 w; w.x = cvt_pk_bf16(v0.x, v0.y); w.y = cvt_pk_bf16(v0.z, v0.w); w.z = cvt_pk_bf16(v1.x, v1.y); w.w = cvt_pk_bf16(v1.z, v1.w);
                            *(u32x4*)(a.o16 + (size_t)row * a.ldc + col) = w;
                        } else if constexpr (MODE == EP_F32SCALE) {
                            *(f32x4*)(a.o32 + (size_t)row * DM + col) = v0; *(f32x4*)(a.o32 + (size_t)row * DM + col + 4) = v1;
                        } else {
                            const size_t off = (size_t)row * DM + col;
                            f32x4 r0, r1;
                            if constexpr (MODE == EP_RES32) { r0 = r32[mm][bj][0]; r1 = r32[mm][bj][1]; }
                            else { const u32x4 rq = rw[mm][bj]; r0 = (f32x4){bf_lo(rq.x), bf_hi(rq.x), bf_lo(rq.y), bf_hi(rq.y)}; r1 = (f32x4){bf_lo(rq.z), bf_hi(rq.z), bf_lo(rq.w), bf_hi(rq.w)}; }
                            if constexpr (MODE == EP_GATE) {
                                const f32x4 b0 = gb[bj][0], b1 = gb[bj][1];
                                const u32x4 pw = pwv[mm][bj];
                                v0 = v0 + b0; v1 = v1 + b1;
                                v0.x = sigmoidf_(v0.x) * bf_lo(pw.x); v0.y = sigmoidf_(v0.y) * bf_hi(pw.x); v0.z = sigmoidf_(v0.z) * bf_lo(pw.y); v0.w = sigmoidf_(v0.w) * bf_hi(pw.y);
                                v1.x = sigmoidf_(v1.x) * bf_lo(pw.z); v1.y = sigmoidf_(v1.y) * bf_hi(pw.z); v1.z = sigmoidf_(v1.z) * bf_lo(pw.w); v1.w = sigmoidf_(v1.w) * bf_hi(pw.w);
                            }
                            v0 = v0 + r0; v1 = v1 + r1;
                            u32x4 w; w.x = cvt_pk_bf16(v0.x, v0.y); w.y = cvt_pk_bf16(v0.z, v0.w); w.z = cvt_pk_bf16(v1.x, v1.y); w.w = cvt_pk_bf16(v1.z, v1.w);
                            *(u32x4*)(a.xbo + off) = w;
                            v0 = (f32x4){bf_lo(w.x), bf_hi(w.x), bf_lo(w.y), bf_hi(w.y)}; v1 = (f32x4){bf_lo(w.z), bf_hi(w.z), bf_lo(w.w), bf_hi(w.w)};
                            ssq += (v0.x * v0.x + v0.y * v0.y) + (v0.z * v0.z + v0.w * v0.w) + (v1.x * v1.x + v1.y * v1.y) + (v1.z * v1.z + v1.w * v1.w);
                        }
                    }
                    if constexpr (IS_RES) {
                        const int ln_ = fq * 16 + fr; ssq += shx(ssq, 16, ln_); ssq += shx(ssq, 32, ln_);
                        if (fq == 0) atomicAdd(a.ss_out + row, ssq);
                    }
                }
              }
        }
    }
};

struct Args { const float* in[19]; float* out; unsigned char* ws; int ph_lo, ph_hi; };
struct Frame {
    LAS unsigned char* lds; int tid, lane, wave, G, bid;
    unsigned char* ws; float* out;
};

__device__ __forceinline__ float wave_sum(float v, int lane) {
#pragma unroll
    for (int o = 1; o < 64; o <<= 1) v += shx(v, o, lane);
    return v;
}

__device__ __forceinline__ void transpose_item(const float* W, int N, int k0, int n0, bf16_t* WT, int ldt, int drow0, const float* kgain, const float* ngain, float scale, LAS float* scr, int lane) {
    const int nn = n0 + (lane & 31);
    float v[32];
#pragma unroll
    for (int i = 0; i < 32; ++i) v[i] = (nn < N) ? W[(size_t)(k0 + 2 * i + (lane >> 5)) * N + nn] : 0.f;
#pragma unroll
    for (int i = 0; i < 32; ++i) scr[(2 * i + (lane >> 5)) * 33 + (lane & 31)] = v[i];
    asm volatile("s_waitcnt lgkmcnt(0)" ::: "memory");
    const int c = lane & 7;
    f32x4 g0 = {1.f, 1.f, 1.f, 1.f}, g1 = g0;
    if (kgain) { g0 = *(const f32x4*)(kgain + k0 + 8 * c); g1 = *(const f32x4*)(kgain + k0 + 8 * c + 4); }
#pragma unroll
    for (int j = 0; j < 4; ++j) { const int n = (lane >> 3) + 8 * j; const LAS float* s = scr + (8 * c) * 33 + n;
        float sc = scale; if (ngain) sc *= ngain[n0 + n];
        u32x4 o; o.x = cvt_pk_bf16(s[0 * 33] * sc * g0.x, s[1 * 33] * sc * g0.y); o.y = cvt_pk_bf16(s[2 * 33] * sc * g0.z, s[3 * 33] * sc * g0.w);
        o.z = cvt_pk_bf16(s[4 * 33] * sc * g1.x, s[5 * 33] * sc * g1.y); o.w = cvt_pk_bf16(s[6 * 33] * sc * g1.z, s[7 * 33] * sc * g1.w);
        *(u32x4*)(WT + (size_t)(drow0 + n) * ldt + k0 + 8 * c) = o; }
    asm volatile("s_waitcnt lgkmcnt(0)" ::: "memory");
}

__device__ __forceinline__ void p0_prologue(const Frame& F, const Args& A) {
    LAS float* scr = (LAS float*)(F.lds + F.wave * 16384);
    const int gw = F.bid * 8 + F.wave, NGW = F.G * 8;
    bf16_t* WB = (bf16_t*)(F.ws + WS_W);
    const float* norm_mix = A.in[2]; const float* norm_mlp = A.in[3]; const float* norm_ple = A.in[4];
    constexpr int I_WIN = 16 * 97, I_SQ = 16 * 32, I_GRP = 4 * 4 * 8, I_W1 = 16 * 128, I_W2 = 64 * 32, I_PLE = 4 * 32;
    constexpr int NITEMS = I_WIN + 3 * I_SQ + I_GRP + 2 * I_W1 + 2 * I_W2 + 2 * I_PLE + 2 * I_SQ;
    for (int it = gw; it < NITEMS; it += NGW) {
        int r = it;
        if (r < I_WIN) {
            const int kb = r / 97, nb = r % 97, n0 = nb * 32; int drow; float sc = 1.f;
            if (n0 < 512) drow = n0; else if (n0 < 1024) { drow = NA + (n0 - 512); sc = 0.08838834764831845f; } else if (n0 < 2048) drow = NA + 512 + (n0 - 1024); else if (n0 < 3072) drow = 512 + (n0 - 2048); else drow = 1536 + (n0 - 3072);
            transpose_item(A.in[6], WIN_N, kb * 64, n0, WB + WO_WIN, 1024, drow, norm_mix, nullptr, sc, scr, F.lane); continue; }
        r -= I_WIN;
        if (r < I_SQ) { transpose_item(A.in[9], 1024, (r / 32) * 64, (r % 32) * 32, WB + WO_WOUT, 1024, (r % 32) * 32, nullptr, nullptr, 1.f, scr, F.lane); continue; }
        r -= I_SQ;
        if (r < I_SQ) { transpose_item(A.in[10], 1024, (r / 32) * 64, (r % 32) * 32, WB + WO_PIN, 1024, (r % 32) * 32, norm_mix + DM, nullptr, 1.f, scr, F.lane); continue; }
        r -= I_SQ;
        if (r < I_GRP) { const int g = r / 32, q = r % 32;
            transpose_item(A.in[11] + (size_t)g * 65536, 256, (q / 8) * 64, (q % 8) * 32, WB + WO_GRP, 256, g * 256 + (q % 8) * 32, nullptr, A.in[12] + g * 256, 1.f, scr, F.lane); continue; }
        r -= I_GRP;
        if (r < I_SQ) { transpose_item(A.in[13], 1024, (r / 32) * 64, (r % 32) * 32, WB + WO_POUT, 1024, (r % 32) * 32, nullptr, nullptr, 1.f, scr, F.lane); continue; }
        r -= I_SQ;
        if (r < 2 * I_W1) { const int l = r / I_W1, q = r % I_W1;
            transpose_item(A.in[14] + (size_t)l * 1024 * 4096, 4096, (q / 128) * 64, (q % 128) * 32, WB + WO_W1 + (size_t)l * 4096 * 1024, 1024, (q % 128) * 32, norm_mlp + l * DM, nullptr, 1.f, scr, F.lane); continue; }
        r -= 2 * I_W1;
        if (r < 2 * I_W2) { const int l = r / I_W2, q = r % I_W2;
            transpose_item(A.in[15] + (size_t)l * 1024 * 4096, 1024, (q / 32) * 64, (q % 32) * 32, WB + WO_W2 + (size_t)l * 4096 * 1024, 4096, (q % 32) * 32, nullptr, nullptr, 1.f, scr, F.lane); continue; }
        r -= 2 * I_W2;
        if (r < 2 * I_PLE) { const int l = r / I_PLE, q = r % I_PLE;
            transpose_item(A.in[16] + (size_t)l * 256 * 1024, 1024, (q / 32) * 64, (q % 32) * 32, WB + WO_PLE + (size_t)l * 1024 * 256, 256, (q % 32) * 32, nullptr, nullptr, 1.f, scr, F.lane); continue; }
        r -= 2 * I_PLE;
        { const int l = r / I_SQ, q = r % I_SQ;
            transpose_item(A.in[17] + (size_t)l * 1024 * 1024, 1024, (q / 32) * 64, (q % 32) * 32, WB + WO_GATE + (size_t)l * 1024 * 1024, 1024, (q % 32) * 32, norm_ple + l * DM, nullptr, 1.f, scr, F.lane); }
    }
    const int gt = F.bid * 512 + F.tid, NGT = F.G * 512;
    { u32x4* z = (u32x4*)(WB + WO_WIN + (size_t)1568 * 1024); const u32x4 zz = {0u, 0u, 0u, 0u};
      for (int i = gt; i < 224 * 1024 / 8; i += NGT) z[i] = zz; }
    { f32x4* z = (f32x4*)(F.ws + WS_SS) + M / 4; const f32x4 zz = {0.f, 0.f, 0.f, 0.f};
      for (int i = gt; i < 6 * M / 4; i += NGT) z[i] = zz; }
    { const float* x = A.in[0]; bf16_t* XB = (bf16_t*)(F.ws + WS_XB); float* SS = (float*)(F.ws + WS_SS);
      for (int m0 = gw * 4; m0 < M; m0 += NGW * 4) {
          f32x4 v[4][4];
#pragma unroll
          for (int r = 0; r < 4; ++r) { const f32x4* xr = (const f32x4*)(x + (size_t)(m0 + r) * DM) + F.lane;
#pragma unroll
              for (int j = 0; j < 4; ++j) v[r][j] = xr[64 * j]; }
#pragma unroll
          for (int r = 0; r < 4; ++r) { float s = 0.f;
#pragma unroll
              for (int j = 0; j < 4; ++j) s += (v[r][j].x * v[r][j].x + v[r][j].y * v[r][j].y) + (v[r][j].z * v[r][j].z + v[r][j].w * v[r][j].w);
              s = wave_sum(s, F.lane);
              u32x2* o8 = (u32x2*)(XB + (size_t)(m0 + r) * DM) + F.lane;
#pragma unroll
              for (int j = 0; j < 4; ++j) { u32x2 w; w.x = cvt_pk_bf16(v[r][j].x, v[r][j].y); w.y = cvt_pk_bf16(v[r][j].z, v[r][j].w); o8[64 * j] = w; }
              if (F.lane == 0) SS[m0 + r] = s; } } }
    { const f32x4* p = (const f32x4*)A.in[1]; u32x2* o = (u32x2*)(F.ws + WS_PB);
      for (int i = gt; i < 2 * M * PLE / 4; i += NGT * 8) { f32x4 v[8];
#pragma unroll
          for (int j = 0; j < 8; ++j) v[j] = (i + j * NGT < 2 * M * PLE / 4) ? p[i + j * NGT] : (f32x4){0.f, 0.f, 0.f, 0.f};
#pragma unroll
          for (int j = 0; j < 8; ++j) if (i + j * NGT < 2 * M * PLE / 4) { u32x2 w; w.x = cvt_pk_bf16(v[j].x, v[j].y); w.y = cvt_pk_bf16(v[j].z, v[j].w); o[i + j * NGT] = w; } } }
}

__device__ __forceinline__ float logsigmoidf_(float f) { return fminf(f, 0.f) - __logf(1.f + __expf(-fabsf(f))); }
__device__ __forceinline__ void mlstm_scan(const Frame& F, float* cst_base  ) {
    LAS float* Bc = (LAS float*)(F.lds);
    LAS float* Gc = Bc + 8192; LAS float* Pc = Gc + 8192; LAS float* Wc = Pc + 8192;
    LAS float* BL = Wc + 8192; LAS float* ML = BL + 64; LAS float* MC = ML + 64; LAS float* DEC = MC + 68;
    const float* GATES = (const float*)(F.ws + WS_GATES);
    float* TOKV = (float*)(F.ws + WS_TOKV);
    const bf16_t* KT = (const bf16_t*)(F.ws + WS_KT); const bf16_t* VT = (const bf16_t*)(F.ws + WS_VT);
    bf16_t* CST = (bf16_t*)cst_base; float* NST = (float*)(F.ws + WS_NST);
    const int lane = F.lane, wave = F.wave, fr = lane & 15, fq = lane >> 4;
    const int vb = (F.G % 8 == 0) ? (F.bid & 7) * (F.G >> 3) + (F.bid >> 3) : F.bid;
    for (int u = vb; u < 256; u += F.G) {
        const int dvs = u & 7, dir = (u >> 3) & 1, h = (u >> 4) & 3, b = u >> 6;
        const int icol = dir * 8 + h, fcol = dir * 8 + 4 + h;
        const float* gp = GATES + (size_t)b * SEQ * 16;
        for (int cc = wave; cc < NCH; cc += 8) {
            const int oc = dir ? (NCH - 1 - cc) : cc;
            const int p0 = 2 * lane, p1 = p0 + 1, o0 = dir ? 127 - p0 : p0, o1 = dir ? 127 - p1 : p1;
            const float f0 = gp[(size_t)(oc * 128 + o0) * 16 + fcol], i0 = gp[(size_t)(oc * 128 + o0) * 16 + icol];
            const float f1 = gp[(size_t)(oc * 128 + o1) * 16 + fcol], i1 = gp[(size_t)(oc * 128 + o1) * 16 + icol];
            const float a0 = logsigmoidf_(f0), a1 = logsigmoidf_(f1);
            float inc = a0 + a1;
#pragma unroll
            for (int o = 1; o < 64; o <<= 1) { const float t = shup(inc, o, lane); if (lane >= o) inc += t; }
            const float b0 = inc - a1, b1 = inc;
            const float g0 = i0 - b0, g1 = i1 - b1;
            float mx = fmaxf(g0, g1);
#pragma unroll
            for (int o = 1; o < 64; o <<= 1) { const float t = shup(mx, o, lane); if (lane >= o) mx = fmaxf(mx, t); }
            float exm = shup(mx, 1, lane); if (lane == 0) exm = -INFINITY;
            const float pm0 = fmaxf(exm, g0), pm1 = mx;
            Bc[cc * 128 + p0] = b0; Bc[cc * 128 + p1] = b1; Gc[cc * 128 + p0] = g0; Gc[cc * 128 + p1] = g1; Pc[cc * 128 + p0] = pm0; Pc[cc * 128 + p1] = pm1;
            if (lane == 63) { BL[cc] = b1; ML[cc] = b1 + pm1; }
        }
        __syncthreads();
        if (F.tid == 0) { float m = 0.f; MC[0] = 0.f; for (int cc = 0; cc < NCH; ++cc) { const float mn = fmaxf(BL[cc] + m, ML[cc]); DEC[cc] = __expf(BL[cc] + m - mn); m = mn; MC[cc + 1] = m; } }
        __syncthreads();
        for (int idx = F.tid; idx < SEQ; idx += 512) {
            const int cc = idx >> 7, pp = idx & 127, oc = dir ? (NCH - 1 - cc) : cc, o = dir ? 127 - pp : pp;
            const float bb = Bc[idx], g = Gc[idx], pm = Pc[idx], mc = MC[cc], mn = MC[cc + 1];
            Wc[oc * 128 + o] = __expf(BL[cc] + g - mn);
            if (dvs == 0) { const float x1 = -fmaxf(mc, pm); const size_t ti = (size_t)((b * NH + h) * 2 + dir) * SEQ + oc * 128 + o;
                TOKV[ti] = x1; TOKV[(size_t)32 * SEQ + ti] = g; TOKV[(size_t)64 * SEQ + ti] = __expf(x1 - bb); TOKV[(size_t)96 * SEQ + ti] = __expf(mc + x1); }
        }
        __syncthreads();
        const bf16_t* ktp = KT + ((size_t)((b * NH + h) * DK + 16 * wave + fr)) * SEQ + 8 * fq;
        const bf16_t* vdp = VT + ((size_t)((b * NH + h) * DV + 32 * dvs + (lane & 31))) * SEQ + 8 * (2 * wave + (lane >> 5));
        LAS unsigned char* ring = F.lds;
        const int vwo = wave * 1024 + lane * 16;
        const int vro = fr * 16 + fq * 512;
        bf16_t* cso = CST + ((size_t)((b * NH + h) * 2 + dir) * NCH) * DV * DK + (size_t)(32 * dvs + fr) * DK + 16 * wave + 4 * fq;
        float* nso = NST + ((size_t)((b * NH + h) * 2 + dir) * NCH) * DK + 16 * wave + 4 * fq;
        f32x4 c0 = {0.f, 0.f, 0.f, 0.f}, c1 = c0, cn = c0;
        const bf16x8 ones = {0x3F80, 0x3F80, 0x3F80, 0x3F80, 0x3F80, 0x3F80, 0x3F80, 0x3F80};
        u32x4 kr[4][4], vr[4];
#define SCAN_ISSUE(j, cnext) do { const int on_ = dir ? (NCH - 1 - (cnext)) : (cnext); \
            _Pragma("unroll") for (int ks = 0; ks < 4; ++ks) kr[j][ks] = *(const u32x4*)(ktp + on_ * 128 + 32 * ks); \
            vr[j] = *(const u32x4*)(vdp + on_ * 128); } while (0)
        SCAN_ISSUE(0, 0); SCAN_ISSUE(1, 1); SCAN_ISSUE(2, 2); SCAN_ISSUE(3, 3);
#define SCAN_STEP(j) do { const int cc = cb + (j); const int oc = dir ? (NCH - 1 - cc) : cc; \
            u32x4 kc[4]; _Pragma("unroll") for (int ks = 0; ks < 4; ++ks) kc[ks] = kr[j][ks]; \
            *(LAS u32x4*)(ring + (cc & 1) * 8192 + vwo) = vr[j]; \
            asm volatile("s_waitcnt lgkmcnt(0)" ::: "memory"); __builtin_amdgcn_s_barrier(); asm volatile("" ::: "memory"); \
            if (cc + 4 < NCH) SCAN_ISSUE(j, cc + 4); \
            { u32x2 w0_, w1_; w0_.x = cvt_pk_bf16(c0.x, c0.y); w0_.y = cvt_pk_bf16(c0.z, c0.w); w1_.x = cvt_pk_bf16(c1.x, c1.y); w1_.y = cvt_pk_bf16(c1.z, c1.w); \
              bf16_t* p0_ = cso + (size_t)oc * DV * DK; bf16_t* p1_ = p0_ + 16 * DK; \
              asm volatile("global_store_dwordx2 %0, %1, off\n\tglobal_store_dwordx2 %2, %3, off" :: "v"(p0_), "v"(w0_), "v"(p1_), "v"(w1_) : "memory"); \
              if (dvs == 0 && fr == 0) { float* pn_ = nso + (size_t)oc * DK; asm volatile("s_nop 7\n\ts_nop 7\n\ts_nop 7\n\tglobal_store_dwordx4 %0, %1, off\n\ts_nop 1" :: "v"(pn_), "v"(cn) : "memory"); } } \
            const float dec = DEC[cc]; \
            const LAS unsigned char* vs = ring + (cc & 1) * 8192 + vro; \
            f32x4 wv[4][2]; bf16x8 vf[4][2]; \
            _Pragma("unroll") for (int ks = 0; ks < 4; ++ks) { wv[ks][0] = *(const LAS f32x4*)(Wc + oc * 128 + 32 * ks + 8 * fq); wv[ks][1] = *(const LAS f32x4*)(Wc + oc * 128 + 32 * ks + 8 * fq + 4); \
                vf[ks][0] = *(const LAS bf16x8*)(vs + ks * 2048); vf[ks][1] = *(const LAS bf16x8*)(vs + ks * 2048 + 256); } \
            c0 = c0 * dec; c1 = c1 * dec; cn = cn * dec; \
            _Pragma("unroll") for (int ks = 0; ks < 4; ++ks) { \
                const f32x4 w0 = wv[ks][0], w1 = wv[ks][1]; \
                u32x4 kw; kw.x = cvt_pk_bf16(bf_lo(kc[ks].x) * w0.x, bf_hi(kc[ks].x) * w0.y); kw.y = cvt_pk_bf16(bf_lo(kc[ks].y) * w0.z, bf_hi(kc[ks].y) * w0.w); \
                kw.z = cvt_pk_bf16(bf_lo(kc[ks].z) * w1.x, bf_hi(kc[ks].z) * w1.y); kw.w = cvt_pk_bf16(bf_lo(kc[ks].w) * w1.z, bf_hi(kc[ks].w) * w1.w); \
                const bf16x8 af = __builtin_bit_cast(bf16x8, kw); \
                c0 = __builtin_amdgcn_mfma_f32_16x16x32_bf16(af, vf[ks][0], c0, 0, 0, 0); \
                c1 = __builtin_amdgcn_mfma_f32_16x16x32_bf16(af, vf[ks][1], c1, 0, 0, 0); \
                cn = __builtin_amdgcn_mfma_f32_16x16x32_bf16(af, ones, cn, 0, 0, 0); } } while (0)
#pragma unroll 1
        for (int cb = 0; cb < NCH; cb += 4) { SCAN_STEP(0); SCAN_STEP(1); SCAN_STEP(2); SCAN_STEP(3); }
#undef SCAN_ISSUE
#undef SCAN_STEP
        asm volatile("s_waitcnt vmcnt(0)" ::: "memory");
        __syncthreads();
    }
}

constexpr int PITCH = 272;
__device__ __forceinline__ void mlstm_out(const Frame& F, const float* head_norm, const float* cst_base) {
    LAS unsigned char* PS = F.lds; LAS unsigned char* QF = PS + 128 * PITCH; LAS unsigned char* QBk = QF + 128 * PITCH;
    LAS float* RED = (LAS float*)(QBk + 128 * PITCH);
    const float* TOKV = (const float*)(F.ws + WS_TOKV);
    const bf16_t* QB = (const bf16_t*)(F.ws + WS_QB); const bf16_t* KB = (const bf16_t*)(F.ws + WS_KB); const bf16_t* VT = (const bf16_t*)(F.ws + WS_VT);
    const bf16_t* SO = (const bf16_t*)(F.ws + WS_SO); const bf16_t* CST = (const bf16_t*)cst_base; const float* NST = (const float*)(F.ws + WS_NST);
    bf16_t* HM = (bf16_t*)(F.ws + WS_HM);
    for (int u = F.bid; u < NB * NH * NCH; u += F.G) {
        int lane_ = F.lane, wave_ = F.wave; asm volatile("" : "+v"(lane_), "+s"(wave_));
        const int lane = lane_, wave = wave_, fr = lane & 15, fq = lane >> 4;
        const int oc = u & 63, h = (u >> 6) & 3, b = u >> 8;
        const int tl = oc * 128; const size_t T0 = (size_t)b * SEQ + tl;
        const int bh = b * NH + h;
        bf16x8 Vf[2][4], Cf[2][4], Cb[2][4];
#pragma unroll
        for (int vt = 0; vt < 2; ++vt) { const int vrow = 32 * wave + 16 * vt + fr;
#pragma unroll
            for (int ks = 0; ks < 4; ++ks) {
                Vf[vt][ks] = *(const bf16x8*)(VT + ((size_t)(bh * DV + vrow)) * SEQ + tl + 32 * ks + 8 * fq);
                Cf[vt][ks] = *(const bf16x8*)(CST + (((size_t)(bh * 2 + 0) * NCH + oc) * DV + vrow) * DK + 32 * ks + 8 * fq); } }
        const int t = 16 * wave + fr;
        u32x4 Qr[4];
#pragma unroll
        for (int ks = 0; ks < 4; ++ks) Qr[ks] = *(const u32x4*)(QB + (T0 + t) * 512 + h * DK + 32 * ks + 8 * fq);
        f32x4 S[8];
        const bf16_t* kp = KB + (T0 + fr) * 512 + h * DK + 8 * fq;
#pragma unroll
        for (int st = 0; st < 8; ++st) { S[st] = (f32x4){0.f, 0.f, 0.f, 0.f};
            asm volatile("" : "+v"(kp));
#pragma unroll
            for (int ks = 0; ks < 4; ++ks) { const bf16x8 kf = *(const bf16x8*)(kp + 32 * ks);
                S[st] = __builtin_amdgcn_mfma_f32_16x16x32_bf16(kf, __builtin_bit_cast(bf16x8, Qr[ks]), S[st], 0, 0, 0); }
            kp += 16 * 512; }
        const size_t gf = (size_t)(bh * 2 + 0) * SEQ + tl, gb = (size_t)(bh * 2 + 1) * SEQ + tl;
        const float x1f = TOKV[gf + t], emf = TOKV[(size_t)64 * SEQ + gf + t], inf_ = TOKV[(size_t)96 * SEQ + gf + t];
        const float x1b = TOKV[gb + t], emb = TOKV[(size_t)64 * SEQ + gb + t], inb_ = TOKV[(size_t)96 * SEQ + gb + t];
        float sumf = 0.f, sumb = 0.f;
#pragma unroll
        for (int st = 0; st < 8; ++st) {
            const f32x4 g4f = *(const f32x4*)(TOKV + (size_t)32 * SEQ + gf + 16 * st + 4 * fq), g4b = *(const f32x4*)(TOKV + (size_t)32 * SEQ + gb + 16 * st + 4 * fq);
            const int s0 = 16 * st + 4 * fq;
            f32x4 pf, pb;
            pf.x = (s0 + 0 <= t) ? S[st].x * __expf(x1f + g4f.x) : 0.f; pf.y = (s0 + 1 <= t) ? S[st].y * __expf(x1f + g4f.y) : 0.f;
            pf.z = (s0 + 2 <= t) ? S[st].z * __expf(x1f + g4f.z) : 0.f; pf.w = (s0 + 3 <= t) ? S[st].w * __expf(x1f + g4f.w) : 0.f;
            pb.x = (s0 + 0 >= t) ? S[st].x * __expf(x1b + g4b.x) : 0.f; pb.y = (s0 + 1 >= t) ? S[st].y * __expf(x1b + g4b.y) : 0.f;
            pb.z = (s0 + 2 >= t) ? S[st].z * __expf(x1b + g4b.z) : 0.f; pb.w = (s0 + 3 >= t) ? S[st].w * __expf(x1b + g4b.w) : 0.f;
            sumf += (pf.x + pf.y) + (pf.z + pf.w); sumb += (pb.x + pb.y) + (pb.z + pb.w);
        }
        float qnf = 0.f, qnb = 0.f;
        const float* nf = NST + ((size_t)(bh * 2 + 0) * NCH + oc) * DK; const float* nb = NST + ((size_t)(bh * 2 + 1) * NCH + oc) * DK;
#pragma unroll
        for (int ks = 0; ks < 4; ++ks) {
            const f32x4 a0 = *(const f32x4*)(nf + 32 * ks + 8 * fq), a1 = *(const f32x4*)(nf + 32 * ks + 8 * fq + 4), b0 = *(const f32x4*)(nb + 32 * ks + 8 * fq), b1 = *(const f32x4*)(nb + 32 * ks + 8 * fq + 4);
            const float q0 = bf_lo(Qr[ks].x), q1 = bf_hi(Qr[ks].x), q2 = bf_lo(Qr[ks].y), q3 = bf_hi(Qr[ks].y), q4 = bf_lo(Qr[ks].z), q5 = bf_hi(Qr[ks].z), q6 = bf_lo(Qr[ks].w), q7 = bf_hi(Qr[ks].w);
            qnf += (q0 * a0.x + q1 * a0.y) + (q2 * a0.z + q3 * a0.w) + (q4 * a1.x + q5 * a1.y) + (q6 * a1.z + q7 * a1.w);
            qnb += (q0 * b0.x + q1 * b0.y) + (q2 * b0.z + q3 * b0.w) + (q4 * b1.x + q5 * b1.y) + (q6 * b1.z + q7 * b1.w);
        }
        sumf += shx(sumf, 16, lane); sumf += shx(sumf, 32, lane); sumb += shx(sumb, 16, lane); sumb += shx(sumb, 32, lane);
        qnf += shx(qnf, 16, lane); qnf += shx(qnf, 32, lane); qnb += shx(qnb, 16, lane); qnb += shx(qnb, 32, lane);
        const float rdf = 1.0f / fmaxf(fabsf(sumf + inf_ * qnf), emf), rdb = 1.0f / fmaxf(fabsf(sumb + inb_ * qnb), emb);
        asm volatile("" ::: "memory");
#pragma unroll
        for (int st = 0; st < 8; ++st) {
            const f32x4 g4f = *(const f32x4*)(TOKV + (size_t)32 * SEQ + gf + 16 * st + 4 * fq), g4b = *(const f32x4*)(TOKV + (size_t)32 * SEQ + gb + 16 * st + 4 * fq);
            const int s0 = 16 * st + 4 * fq;
            f32x4 p;
            p.x = S[st].x * (((s0 + 0 <= t) ? __expf(x1f + g4f.x) * rdf : 0.f) + ((s0 + 0 >= t) ? __expf(x1b + g4b.x) * rdb : 0.f));
            p.y = S[st].y * (((s0 + 1 <= t) ? __expf(x1f + g4f.y) * rdf : 0.f) + ((s0 + 1 >= t) ? __expf(x1b + g4b.y) * rdb : 0.f));
            p.z = S[st].z * (((s0 + 2 <= t) ? __expf(x1f + g4f.z) * rdf : 0.f) + ((s0 + 2 >= t) ? __expf(x1b + g4b.z) * rdb : 0.f));
            p.w = S[st].w * (((s0 + 3 <= t) ? __expf(x1f + g4f.w) * rdf : 0.f) + ((s0 + 3 >= t) ? __expf(x1b + g4b.w) * rdb : 0.f));
            u32x2 w; w.x = cvt_pk_bf16(p.x, p.y); w.y = cvt_pk_bf16(p.z, p.w);
            *(LAS u32x2*)(PS + t * PITCH + (16 * st + 4 * fq) * 2) = w; }
        { const float sf = inf_ * rdf, sb = inb_ * rdb;
#pragma unroll
          for (int ks = 0; ks < 4; ++ks) {
              const float q0 = bf_lo(Qr[ks].x), q1 = bf_hi(Qr[ks].x), q2 = bf_lo(Qr[ks].y), q3 = bf_hi(Qr[ks].y), q4 = bf_lo(Qr[ks].z), q5 = bf_hi(Qr[ks].z), q6 = bf_lo(Qr[ks].w), q7 = bf_hi(Qr[ks].w);
              u32x4 w; w.x = cvt_pk_bf16(q0 * sf, q1 * sf); w.y = cvt_pk_bf16(q2 * sf, q3 * sf); w.z = cvt_pk_bf16(q4 * sf, q5 * sf); w.w = cvt_pk_bf16(q6 * sf, q7 * sf);
              *(LAS u32x4*)(QF + t * PITCH + (32 * ks + 8 * fq) * 2) = w;
              w.x = cvt_pk_bf16(q0 * sb, q1 * sb); w.y = cvt_pk_bf16(q2 * sb, q3 * sb); w.z = cvt_pk_bf16(q4 * sb, q5 * sb); w.w = cvt_pk_bf16(q6 * sb, q7 * sb);
              *(LAS u32x4*)(QBk + t * PITCH + (32 * ks + 8 * fq) * 2) = w; } }
#pragma unroll
        for (int vt = 0; vt < 2; ++vt) { const int vrow = 32 * wave + 16 * vt + fr;
#pragma unroll
            for (int ks = 0; ks < 4; ++ks) Cb[vt][ks] = *(const bf16x8*)(CST + (((size_t)(bh * 2 + 1) * NCH + oc) * DV + vrow) * DK + 32 * ks + 8 * fq); }
        __syncthreads();
        f32x4 acc[8][2];
#pragma unroll
        for (int tt = 0; tt < 8; ++tt) {
            acc[tt][0] = (f32x4){0.f, 0.f, 0.f, 0.f}; acc[tt][1] = acc[tt][0];
            const int ro = (16 * tt + fr) * PITCH + 16 * fq;
#pragma unroll
            for (int ks = 0; ks < 4; ++ks) { const bf16x8 p = *(const LAS bf16x8*)(PS + ro + 64 * ks);
                acc[tt][0] = __builtin_amdgcn_mfma_f32_16x16x32_bf16(Vf[0][ks], p, acc[tt][0], 0, 0, 0); acc[tt][1] = __builtin_amdgcn_mfma_f32_16x16x32_bf16(Vf[1][ks], p, acc[tt][1], 0, 0, 0); }
#pragma unroll
            for (int ks = 0; ks < 4; ++ks) { const bf16x8 p = *(const LAS bf16x8*)(QF + ro + 64 * ks);
                acc[tt][0] = __builtin_amdgcn_mfma_f32_16x16x32_bf16(Cf[0][ks], p, acc[tt][0], 0, 0, 0); acc[tt][1] = __builtin_amdgcn_mfma_f32_16x16x32_bf16(Cf[1][ks], p, acc[tt][1], 0, 0, 0); }
        }
#pragma unroll
        for (int tt = 0; tt < 8; ++tt) {
            const int ro = (16 * tt + fr) * PITCH + 16 * fq;
#pragma unroll
            for (int ks = 0; ks < 4; ++ks) { const bf16x8 p = *(const LAS bf16x8*)(QBk + ro + 64 * ks);
                acc[tt][0] = __builtin_amdgcn_mfma_f32_16x16x32_bf16(Cb[0][ks], p, acc[tt][0], 0, 0, 0); acc[tt][1] = __builtin_amdgcn_mfma_f32_16x16x32_bf16(Cb[1][ks], p, acc[tt][1], 0, 0, 0); }
            float ss = 0.f;
#pragma unroll
            for (int vt = 0; vt < 2; ++vt) ss += (acc[tt][vt].x * acc[tt][vt].x + acc[tt][vt].y * acc[tt][vt].y) + (acc[tt][vt].z * acc[tt][vt].z + acc[tt][vt].w * acc[tt][vt].w);
            ss += shx(ss, 16, lane); ss += shx(ss, 32, lane);
            if (fq == 0) RED[wave * 128 + 16 * tt + fr] = ss;
        }
        __syncthreads();
        { const int col0 = h * DV + 32 * wave + 4 * fq;
          const f32x4 hn0 = *(const f32x4*)(head_norm + col0), hn1 = *(const f32x4*)(head_norm + col0 + 16);
          size_t off = (T0 + fr) * 1024 + col0;
#pragma unroll
          for (int tt = 0; tt < 8; ++tt) {
            asm volatile("" : "+v"(off));
            float tot = 0.f;
#pragma unroll
            for (int w = 0; w < 8; ++w) tot += RED[w * 128 + 16 * tt + fr];
            const float rstd = rsqrtf(tot * (1.f / DV) + EPS);
#pragma unroll
            for (int vt = 0; vt < 2; ++vt) {
                const f32x4 hn = vt ? hn1 : hn0; const u32x2 so = *(const u32x2*)(SO + off + 16 * vt);
                const f32x4 a = acc[tt][vt]; u32x2 w;
                w.x = cvt_pk_bf16(a.x * rstd * hn.x * bf_lo(so.x), a.y * rstd * hn.y * bf_hi(so.x)); w.y = cvt_pk_bf16(a.z * rstd * hn.z * bf_lo(so.y), a.w * rstd * hn.w * bf_hi(so.y));
                *(u32x2*)(HM + off + 16 * vt) = w; }
            off += 16 * 1024;
          } }
        __syncthreads();
    }
}

__device__ __forceinline__ void gates_direct(const Frame& F, const float* bias) {
    const bf16_t* XB = (const bf16_t*)(F.ws + WS_XB); const bf16_t* WG = (const bf16_t*)(F.ws + WS_W) + WO_WIN + (size_t)1536 * DM;
    const float* SS = (const float*)(F.ws + WS_SS); float* GATES = (float*)(F.ws + WS_GATES);
    const int lane = F.lane, fr = lane & 15, fq = lane >> 4;
    for (int tile = F.bid * 8 + F.wave; tile < M / 16; tile += F.G * 8) {
        const bf16_t* ap = XB + (size_t)(tile * 16 + fr) * DM + 8 * fq; const bf16_t* bp = WG + (size_t)fr * DM + 8 * fq;
        f32x4 acc = {0.f, 0.f, 0.f, 0.f};
#pragma unroll 8
        for (int ks = 0; ks < 32; ++ks) { const bf16x8 a = *(const bf16x8*)(ap + 32 * ks), b = *(const bf16x8*)(bp + 32 * ks);
            acc = __builtin_amdgcn_mfma_f32_16x16x32_bf16(a, b, acc, 0, 0, 0); }
        const int row0 = tile * 16 + 4 * fq; const float bv = bias[fr];
        const f32x4 s4 = *(const f32x4*)(SS + row0);
        GATES[(size_t)(row0 + 0) * 16 + fr] = acc.x * rsqrtf(s4.x * (1.f / DM) + EPS) + bv; GATES[(size_t)(row0 + 1) * 16 + fr] = acc.y * rsqrtf(s4.y * (1.f / DM) + EPS) + bv;
        GATES[(size_t)(row0 + 2) * 16 + fr] = acc.z * rsqrtf(s4.z * (1.f / DM) + EPS) + bv; GATES[(size_t)(row0 + 3) * 16 + fr] = acc.w * rsqrtf(s4.w * (1.f / DM) + EPS) + bv;
    }
}

template <int HALF>
__device__ __forceinline__ void pool_item(const bf16_t* U, bf16_t* Y0, size_t row0, int bt0, int q, int g) {
    constexpr int NR = 2 * HALF + 3;
    f32x4 r[NR];
    u32x2 w_[NR];
#pragma unroll
    for (int i = 0; i < NR; ++i) { int tt = bt0 - HALF + i; tt = tt < 0 ? 0 : (tt > SEQ - 1 ? SEQ - 1 : tt);
        w_[i] = *((const u32x2*)(U + (row0 - bt0 + tt) * 1024) + q); }
#pragma unroll
    for (int i = 0; i < NR; ++i) { const int tt = bt0 - HALF + i; const float mk = (tt >= 0 && tt < SEQ) ? 1.f : 0.f;
        r[i] = (f32x4){bf_lo(w_[i].x) * mk, bf_hi(w_[i].x) * mk, bf_lo(w_[i].y) * mk, bf_hi(w_[i].y) * mk}; }
#pragma unroll
    for (int j = 0; j < 4; ++j) { const int t = bt0 + j; int lo = t - HALF; if (lo < 0) lo = 0; int hi = t + HALF; if (hi > SEQ) hi = SEQ;
        f32x4 sum = r[j];
#pragma unroll
        for (int i = 1; i < 2 * HALF; ++i) sum += r[j + i];
        const f32x4 y = sum * (1.0f / (float)(hi - lo)) - r[j + HALF];
        u32x2 w; w.x = cvt_pk_bf16(y.x, y.y); w.y = cvt_pk_bf16(y.z, y.w);
        *((u32x2*)(Y0 + ((size_t)g * M + row0 + j) * 256) + (q & 63)) = w; }
}
__device__ __forceinline__ void pool_phase(const Frame& F) {
    const bf16_t* U1 = (const bf16_t*)(F.ws + WS_U1); bf16_t* Y0 = (bf16_t*)(F.ws + WS_Y0);
    const int gt = F.bid * 512 + F.tid, NGT = F.G * 512;
    for (int it = gt; it < (M / 4) * 256; it += NGT) {
        const int q = it & 255, tb = it >> 8; const int g = q >> 6;
        const size_t row0 = (size_t)tb * 4; const int bt0 = (int)(row0 & (SEQ - 1));
        if (g == 0) pool_item<1>(U1, Y0, row0, bt0, q, g); else if (g == 1) pool_item<2>(U1, Y0, row0, bt0, q, g);
        else if (g == 2) pool_item<4>(U1, Y0, row0, bt0, q, g); else pool_item<8>(U1, Y0, row0, bt0, q, g);
    }
}

__device__ __forceinline__ void final_phase(const Frame& F, const float* gain, const float* ss, const bf16_t* hb) {
    const int gw = F.bid * 8 + F.wave, NGW = F.G * 8;
    const f32x4* gr = (const f32x4*)gain + F.lane;
    for (int m0 = gw * 4; m0 < M; m0 += NGW * 4) {
        u32x2 w[4][4]; float r[4];
#pragma unroll
        for (int q = 0; q < 4; ++q) { const u32x2* hr = (const u32x2*)(hb + (size_t)(m0 + q) * DM) + F.lane; r[q] = rsqrtf(ss[m0 + q] * (1.f / DM) + EPS);
#pragma unroll
            for (int j = 0; j < 4; ++j) w[q][j] = hr[64 * j]; }
#pragma unroll
        for (int q = 0; q < 4; ++q) { f32x4* xr = (f32x4*)(F.out + (size_t)(m0 + q) * DM) + F.lane;
#pragma unroll
            for (int j = 0; j < 4; ++j) { const f32x4 v = {bf_lo(w[q][j].x), bf_hi(w[q][j].x), bf_lo(w[q][j].y), bf_hi(w[q][j].y)}; xr[64 * j] = v * r[q] * gr[64 * j]; } }
    }
}

#define XB_TMO      128
#define XB_XCNT(j)  (256  + 64 * (j))
#define XB_XSUB(j)  (1280 + 64 * (j))
#define XB_XGEN(j)  (2304 + 64 * (j))
#define XB_TOP      3328
#define XB_TOPGEN   3392
#define XCD_BAR_WORDS 3456
#define XB_SPIN_CAP (1u << 22)
__device__ __forceinline__ unsigned xb_ld(unsigned* p)              { return __hip_atomic_load(p, __ATOMIC_RELAXED, __HIP_MEMORY_SCOPE_AGENT); }
__device__ __forceinline__ unsigned xb_add(unsigned* p, unsigned v) { return __hip_atomic_fetch_add(p, v, __ATOMIC_RELAXED, __HIP_MEMORY_SCOPE_AGENT); }
__device__ __forceinline__ unsigned xb_xcc_id() { return (unsigned)__builtin_amdgcn_s_getreg((3 << 11) | 20) & 0xFu; }
#define XB_SPIN(cond, bar) do { unsigned _sp = 0; while (cond) { __builtin_amdgcn_s_sleep(1); \
    if ((++_sp & 255u) == 0u) { if (xb_ld(&(bar)[XB_TMO])) break; if (_sp > XB_SPIN_CAP) { atomicAdd(&(bar)[XB_TMO], 1u); break; } } } } while (0)
__device__ __forceinline__ void xcd_barrier_complete(unsigned* bar, unsigned x, unsigned& nloc, unsigned& nx) {
    const unsigned G = gridDim.x;
    unsigned sum, cnt, mine, sp = 0u;
    for (;;) {
        sum = 0u; cnt = 0u; mine = 0u;
#pragma unroll
        for (unsigned j = 0; j < 16; ++j) { const unsigned c = xb_ld(&bar[XB_XCNT(j)]); sum += c; cnt += (c > 0u) ? 1u : 0u; mine = (j == x) ? c : mine; }
        if (sum == G) break;
        __builtin_amdgcn_s_sleep(1);
        if ((++sp & 255u) == 0u) { if (xb_ld(&bar[XB_TMO])) break; if (sp > XB_SPIN_CAP) { atomicAdd(&bar[XB_TMO], 1u); break; } }
    }
    nloc = mine > 0u ? mine : 1u; nx = cnt > 0u ? cnt : 1u;
}
__device__ __forceinline__ void xcd_barrier(unsigned* bar, volatile LAS unsigned* st, int tid) {
    asm volatile("s_waitcnt vmcnt(0)" ::: "memory");
    __syncthreads();
    if (tid == 0) {
        __builtin_amdgcn_s_waitcnt(0);
        const unsigned x = xb_xcc_id();
        unsigned nloc = st[0], nx = st[1];
        if (nloc == 0u) { xcd_barrier_complete(bar, x, nloc, nx); st[0] = nloc; st[1] = nx; }
        const unsigned old = xb_add(&bar[XB_XSUB(x)], 1u);
        const unsigned gen = old / nloc;
        if (old + 1u == (gen + 1u) * nloc) {
            __builtin_amdgcn_fence(__ATOMIC_RELEASE, "agent");
            asm volatile("s_waitcnt vmcnt(0)" ::: "memory");
            const unsigned og = xb_add(&bar[XB_TOP], 1u);
            const unsigned tg = og / nx;
            if (og + 1u == (tg + 1u) * nx) xb_add(&bar[XB_TOPGEN], 1u);
            else XB_SPIN(xb_ld(&bar[XB_TOPGEN]) == tg, bar);
            __builtin_amdgcn_fence(__ATOMIC_ACQUIRE, "agent");
            xb_add(&bar[XB_XGEN(x)], 1u);
            asm volatile("s_waitcnt vmcnt(0)" ::: "memory");
        } else {
            XB_SPIN(xb_ld(&bar[XB_XGEN(x)]) == gen, bar);
            __builtin_amdgcn_fence(__ATOMIC_ACQUIRE, "agent");
            asm volatile("s_waitcnt vmcnt(0)" ::: "memory");
        }
    }
    __syncthreads();
}

constexpr int N_PHASES = 15;
typedef const __attribute__((address_space(4))) Args* KArgP;
__device__ __forceinline__ Args load_args_() {
    Args a{};
#if defined(__HIP_DEVICE_COMPILE__)
    KArgP p_ = (KArgP)__builtin_amdgcn_kernarg_segment_ptr(); asm volatile("" : "+s"(p_));
#pragma unroll
    for (int i = 0; i < 19; ++i) a.in[i] = p_->in[i];
    a.out = p_->out; a.ws = p_->ws; a.ph_lo = p_->ph_lo; a.ph_hi = p_->ph_hi;
#endif
    return a;
}
#define LOADARGS() load_args_()
#define MKFRAME(A) Frame F; F.lds = (LAS unsigned char*)lds_raw; { int l_ = lane_id_fresh(); F.lane = l_; int b_ = blockIdx.x; asm volatile("" : "+s"(b_)); F.bid = b_; } F.wave = wvid; F.tid = wvid * 64 + F.lane; F.G = gridDim.x; F.ws = (A).ws; F.out = (A).out; \
    unsigned char* ws = (A).ws; bf16_t* WB = (bf16_t*)(ws + WS_W); float* SS = (float*)(ws + WS_SS); bf16_t* XB = (bf16_t*)(ws + WS_XB); bf16_t* XB2 = (bf16_t*)(ws + WS_Y1); bf16_t* HMb = (bf16_t*)(ws + WS_HM); bf16_t* PB = (bf16_t*)(ws + WS_PB); bf16_t* ACT = (bf16_t*)(ws + WS_ACT); \
    (void)WB; (void)SS; (void)XB; (void)XB2; (void)HMb; (void)PB; (void)ACT;
__global__ void __launch_bounds__(512, 2) mk_fwd(Args args) {
    extern __shared__ __attribute__((aligned(16))) unsigned char lds_raw[];
    const int lo = args.ph_lo, hi = args.ph_hi;
#define LCTL ((volatile LAS unsigned*)((LAS unsigned char*)lds_raw + (LDS_BYTES - 64)))
    if (threadIdx.x == 0) { LCTL[0] = 0u; LCTL[1] = 0u; LCTL[2] = 0u; }
    __syncthreads();
    int wvid;
    { const int l0 = lane_id_fresh(); unsigned w = 0u;
      if (l0 == 0) w = __hip_atomic_fetch_add((LAS unsigned*)((LAS unsigned char*)lds_raw + (LDS_BYTES - 64)), 1u, __ATOMIC_RELAXED, __HIP_MEMORY_SCOPE_WORKGROUP);
      wvid = __builtin_amdgcn_readfirstlane((int)w);
      if (MK_MULTI == 0 && wvid == 0 && l0 == 0) (void)xb_add((unsigned*)args.ws + XB_XCNT(xb_xcc_id()), 1u); }
#ifndef PH_MASK
#define PH_MASK 0xFFFF
#endif
#define IN(k) ((((PH_MASK) >> (k)) & 1) && lo <= (k) && (k) < hi)
#define SEAM(k) do { if (lo <= (k) && (k) + 1 < hi) { if ((k) == 0) cg::this_grid().sync(); else { const Args A_ = LOADARGS(); int l_ = lane_id_fresh(); xcd_barrier((unsigned*)A_.ws, LCTL + 1, wvid * 64 + l_); } } } while (0)

    if (IN(0)) { const Args A = LOADARGS(); MKFRAME(A); p0_prologue(F, A); }
    SEAM(0);
    if (IN(1)) {
        const Args A = LOADARGS(); MKFRAME(A);
        gates_direct(F, A.in[7]);
        { pg8::Gemm g{XB, WB + WO_WIN, M, 1536, DM, 0}; pg8::StaticOrder S; S.init(M, 1536, F.G, F.bid);
          Epi<EP_QO> E; E.a = EpiArgs{}; E.a.ss_in = SS; E.a.qb = (bf16_t*)(ws + WS_QB); E.a.so = (bf16_t*)(ws + WS_SO); E.a.gates = (float*)(ws + WS_GATES); E.a.bias = A.in[7];
          pg8::gemm_phase(F.lds, g, S, E, wvid * 64 + lane_id_fresh()); }
        { pg8::Gemm g{XB, WB + WO_WIN + (size_t)NA * DM, M, NBK, DM, 0}; pg8::StaticOrder S; S.init(M, NBK, F.G, F.bid);
          Epi<EP_KV> E; E.a = EpiArgs{}; E.a.ss_in = SS; E.a.kb = (bf16_t*)(ws + WS_KB); E.a.kt = (bf16_t*)(ws + WS_KT); E.a.vt = (bf16_t*)(ws + WS_VT);
          pg8::gemm_phase(F.lds, g, S, E, wvid * 64 + lane_id_fresh()); }
    }
    SEAM(1);
    if (IN(2)) { const Args A = LOADARGS(); MKFRAME(A); mlstm_scan(F, A.out); }
    SEAM(2);
    if (IN(3)) { const Args A = LOADARGS(); MKFRAME(A); mlstm_out(F, A.in[8], A.out); }
    SEAM(3);
    if (IN(4)) {
        const Args A = LOADARGS(); MKFRAME(A);
        pg8::Gemm g{HMb, WB + WO_WOUT, M, DM, DM, 0}; pg8::StaticOrder S; S.init(M, DM, F.G, F.bid);
        Epi<EP_RES32> E; E.a = EpiArgs{}; E.a.res32 = A.in[0]; E.a.xbo = XB; E.a.ss_out = SS + 1 * M;
        pg8::gemm_phase(F.lds, g, S, E, F.tid);
    }
    SEAM(4);
#pragma unroll
    for (int l = 0; l < 2; ++l) {
        const int pb = 5 + 7 * l;
        if (l == 1) {
            if (IN(8)) {
                const Args A = LOADARGS(); MKFRAME(A);
                pg8::Gemm g{XB2, WB + WO_PIN, M, DM, DM, 0}; pg8::StaticOrder S; S.init(M, DM, F.G, F.bid);
                Epi<EP_BF16S> E; E.a = EpiArgs{}; E.a.ss_in = SS + 3 * M; E.a.o16 = (bf16_t*)(ws + WS_U1); E.a.ldc = DM;
                pg8::gemm_phase(F.lds, g, S, E, F.tid);
            }
            SEAM(8);
            if (IN(9)) { const Args A = LOADARGS(); MKFRAME(A); pool_phase(F); }
            SEAM(9);
            if (IN(10)) {
                const Args A = LOADARGS(); MKFRAME(A);
                pg8::Gemm g{(const bf16_t*)(ws + WS_Y0), WB + WO_GRP, M, DM, 256, (size_t)M * 256}; pg8::StaticOrder S; S.init(M, DM, F.G, F.bid);
                Epi<EP_BF16> E; E.a = EpiArgs{}; E.a.o16 = HMb; E.a.ldc = DM;
                pg8::gemm_phase(F.lds, g, S, E, F.tid);
            }
            SEAM(10);
            if (IN(11)) {
                const Args A = LOADARGS(); MKFRAME(A);
                pg8::Gemm g{HMb, WB + WO_POUT, M, DM, DM, 0}; pg8::StaticOrder S; S.init(M, DM, F.G, F.bid);
                Epi<EP_RES> E; E.a = EpiArgs{}; E.a.res16 = XB2; E.a.xbo = XB; E.a.ss_out = SS + 4 * M;
                pg8::gemm_phase(F.lds, g, S, E, F.tid);
            }
            SEAM(11);
        }
        const int si = 1 + 3 * l;
        if (IN(pb)) {
            const Args A = LOADARGS(); MKFRAME(A);
            { pg8::Gemm g{XB, WB + WO_W1 + (size_t)l * FF * DM, M, FF, DM, 0}; pg8::StaticOrder S; S.init(M, FF, F.G, F.bid);
              Epi<EP_SQRELU> E; E.a = EpiArgs{}; E.a.ss_in = SS + si * M; E.a.o16 = ACT; E.a.ldc = FF;
              pg8::gemm_phase(F.lds, g, S, E, F.tid); }
            { pg8::Gemm g{PB + (size_t)l * M * PLE, WB + WO_PLE + (size_t)l * DM * PLE, M, DM, PLE, 0}; pg8::StaticOrder S; S.init(M, DM, F.G, F.bid);
              Epi<EP_BF16> E; E.a = EpiArgs{}; E.a.o16 = HMb; E.a.ldc = DM;
              pg8::gemm_phase(F.lds, g, S, E, wvid * 64 + lane_id_fresh()); }
        }
        SEAM(pb);
        if (IN(pb + 1)) {
            const Args A = LOADARGS(); MKFRAME(A);
            pg8::Gemm g{ACT, WB + WO_W2 + (size_t)l * FF * DM, M, DM, FF, 0}; pg8::StaticOrder S; S.init(M, DM, F.G, F.bid);
            Epi<EP_RES> E; E.a = EpiArgs{}; E.a.res16 = XB; E.a.xbo = XB; E.a.ss_out = SS + (si + 1) * M;
            pg8::gemm_phase(F.lds, g, S, E, F.tid);
        }
        SEAM(pb + 1);
        if (IN(pb + 2)) {
            const Args A = LOADARGS(); MKFRAME(A);
            pg8::Gemm g{XB, WB + WO_GATE + (size_t)l * DM * DM, M, DM, DM, 0}; pg8::StaticOrder S; S.init(M, DM, F.G, F.bid);
            Epi<EP_GATE> E; E.a = EpiArgs{}; E.a.ss_in = SS + (si + 1) * M; E.a.res16 = XB; E.a.xbo = XB2; E.a.ss_out = SS + (si + 2) * M;
            E.a.bias = A.in[18] + l * DM; E.a.pe = HMb;
            pg8::gemm_phase(F.lds, g, S, E, F.tid);
        }
        SEAM(pb + 2);
    }
    if (IN(15)) { const Args A = LOADARGS(); MKFRAME(A); final_phase(F, A.in[5], SS + 6 * M, XB2); }
#undef IN
#undef SEAM
}

extern "C" void kernel_launch(void* const* d_in, const int* in_sizes, int n_in, void* d_out, int out_size, void* d_ws, size_t ws_size, hipStream_t stream) {
    static int grid = 0;
    if (grid == 0) {
        if (n_in != 19 || out_size != M * DM || ws_size < WS_END) { fprintf(stderr, "kernel_launch: unexpected shapes (n_in %d out %d ws %zu)\n", n_in, out_size, ws_size); grid = -1; return; }
        int dev = 0, cus = 0, per_cu = 0;
        hipGetDevice(&dev); hipDeviceGetAttribute(&cus, hipDeviceAttributeMultiprocessorCount, dev);
        hipFuncSetAttribute((const void*)mk_fwd, hipFuncAttributeMaxDynamicSharedMemorySize, LDS_BYTES);
        if (hipOccupancyMaxActiveBlocksPerMultiprocessor(&per_cu, (const void*)mk_fwd, 512, LDS_BYTES) != hipSuccess || per_cu < 1) { fprintf(stderr, "kernel_launch: occupancy query gave %d\n", per_cu); per_cu = 1; }
        (void)hipGetLastError();
        grid = cus * per_cu;
        fprintf(stderr, "kernel_launch: grid %d (cus %d per_cu %d)\n", grid, cus, per_cu);
    }
    if (grid < 0) return;
    Args a{};
    for (int i = 0; i < 19; ++i) a.in[i] = (const float*)d_in[i];
    a.out = (float*)d_out; a.ws = (unsigned char*)d_ws;
    hipMemsetAsync(d_ws, 0, 16384, stream);
#if MK_MULTI
    for (int ph = 0; ph <= N_PHASES; ++ph) { a.ph_lo = ph; a.ph_hi = ph + 1; hipLaunchKernelGGL(mk_fwd, dim3(grid), dim3(512), LDS_BYTES, stream, a); }
#else
    a.ph_lo = 0; a.ph_hi = N_PHASES + 1;
    void* kargs[] = {&a};
    hipError_t e = hipLaunchCooperativeKernel((const void*)mk_fwd, dim3(grid), dim3(512), kargs, LDS_BYTES, stream);
    if (e != hipSuccess) fprintf(stderr, "cooperative launch failed: %s (grid %d)\n", hipGetErrorString(e), grid);
#ifdef PROBE_LIST
    { const int pl[] = {PROBE_LIST}; for (int ph : pl) { Args b = a; b.out = (float*)((unsigned char*)d_ws + WS_U1); b.ph_lo = ph; b.ph_hi = ph + 1; hipLaunchKernelGGL(mk_fwd, dim3(grid), dim3(512), LDS_BYTES, stream, b); } }
#endif
#endif
}
```

```cpp
#include <hip/hip_runtime.h>
#include <hip/hip_cooperative_groups.h>
#include <cstdio>
#include <cstdint>
namespace cg = cooperative_groups;

#ifndef MK_MULTI
#define MK_MULTI 0
#endif

#define LAS __attribute__((address_space(3)))
typedef unsigned short bf16_t;
typedef short bf16x8 __attribute__((ext_vector_type(8)));
typedef float f32x4 __attribute__((ext_vector_type(4)));
typedef float f32x2 __attribute__((ext_vector_type(2)));
typedef unsigned u32x4 __attribute__((ext_vector_type(4)));
typedef unsigned u32x2 __attribute__((ext_vector_type(2)));

constexpr int DM = 1024, NB = 4, SEQ = 8192, M = NB * SEQ, FF = 4096, PLE = 256;
constexpr int NH = 4, DK = 128, DV = 256, LCH = 128, NCH = SEQ / LCH;
constexpr int WIN_N = 3088;
constexpr int NA = 1792, NBK = 1536;
constexpr float EPS = 1e-6f;

constexpr size_t MiB = 1u << 20;
constexpr size_t WS_GATES = 1 * MiB;
constexpr size_t WS_SS = 3 * MiB;
constexpr size_t WS_NST = 4 * MiB;
constexpr size_t WS_TOKV = 5 * MiB;
constexpr size_t WS_W = 10 * MiB;
constexpr size_t WS_XB = 64 * MiB;
constexpr size_t WS_PB = 128 * MiB;
constexpr size_t WS_HM = 160 * MiB;
constexpr size_t WS_U = 224 * MiB;
constexpr size_t WS_QB = WS_U, WS_KB = WS_U + 32 * MiB, WS_KT = WS_U + 64 * MiB, WS_VT = WS_U + 96 * MiB, WS_SO = WS_U + 160 * MiB;
constexpr size_t WS_ACT = 224 * MiB;
constexpr size_t WS_U1 = 224 * MiB;
constexpr size_t WS_Y0 = 352 * MiB;
constexpr size_t WS_Y1 = 416 * MiB;
constexpr size_t WS_END = 480 * MiB;
constexpr size_t WO_WIN = 0;
constexpr size_t WO_WOUT = WO_WIN + (size_t)3328 * 1024;
constexpr size_t WO_PIN = WO_WOUT + (size_t)1024 * 1024;
constexpr size_t WO_GRP = WO_PIN + (size_t)1024 * 1024;
constexpr size_t WO_POUT = WO_GRP + (size_t)1024 * 256;
constexpr size_t WO_W1 = WO_POUT + (size_t)1024 * 1024;
constexpr size_t WO_W2 = WO_W1 + (size_t)2 * 4096 * 1024;
constexpr size_t WO_PLE = WO_W2 + (size_t)2 * 4096 * 1024;
constexpr size_t WO_GATE = WO_PLE + (size_t)2 * 1024 * 256;
constexpr size_t WO_END = WO_GATE + (size_t)2 * 1024 * 1024;
static_assert(WS_W + WO_END * 2 <= WS_XB, "weights fit");

constexpr int LDS_BYTES = 147456;

__device__ __forceinline__ unsigned cvt_pk_bf16(float lo, float hi) { unsigned r; asm volatile("v_cvt_pk_bf16_f32 %0, %1, %2" : "=v"(r) : "v"(lo), "v"(hi)); return r; }
__device__ __forceinline__ float bf_lo(unsigned w) { return __uint_as_float(w << 16); }
__device__ __forceinline__ float bf_hi(unsigned w) { return __uint_as_float(w & 0xffff0000u); }
__device__ __forceinline__ float sigmoidf_(float v) { return 1.0f / (1.0f + __expf(-v)); }

__device__ __forceinline__ float shx(float v, int mask, int lane) { return __int_as_float(__builtin_amdgcn_ds_bpermute((lane ^ mask) << 2, __float_as_int(v))); }
__device__ __forceinline__ float shup(float v, int d, int lane) { return __int_as_float(__builtin_amdgcn_ds_bpermute((lane - d) << 2, __float_as_int(v))); }
__device__ __forceinline__ int lane_id_fresh() { unsigned m = ~0u; asm volatile("" : "+s"(m)); return (int)__builtin_amdgcn_mbcnt_hi(m, __builtin_amdgcn_mbcnt_lo(m, 0u)); }
namespace pg8 {
constexpr int BM = 256, BK = 64, HALF = 128, HTB = HALF * BK * 2, STAGE_BYTES = 8 * HTB, NXCD = 8, WGM = 8;
__host__ __device__ __forceinline__ int lds_byte(int r, int c) { const int st = (r >> 4) * 2 + (c >> 5), rr = r & 15, cc = c & 31, ob = rr * 64 + cc * 2; return st * 1024 + (ob ^ (((ob >> 9) & 1) << 5)); }
__host__ __device__ __forceinline__ void stage_rc(int b, int& R, int& C) { const int st = b / 1024, sb = b % 1024, swz = sb ^ (((sb >> 9) & 1) << 5); R = (st >> 1) * 16 + swz / 64; C = (st & 1) * 32 + (swz % 64) / 2; }
__host__ __device__ __forceinline__ int perm32(int rho) { const int n = rho >> 4, i = rho & 15; return 8 * (i >> 2) + 4 * n + (i & 3); }

struct Unit { int pm, pn; };
struct Gemm { const bf16_t* A; const bf16_t* Bt; int M, N, K; size_t acol; };

struct StaticOrder {
    int nM, nN, nwg, G, c;
    __device__ void init(int M_, int N_, int G_, int c_) { nM = M_ / BM; nN = N_ / BM; nwg = nM * nN; G = G_; c = c_; }
    __device__ bool next(int i, Unit& u) const {
        const long L = (long)i * G + c; if (L >= nwg) return false;
        int wgid = (int)L; { const int q = nwg / NXCD, r = nwg % NXCD, xcd = wgid % NXCD, off = wgid / NXCD; wgid = (xcd < r ? xcd * (q + 1) : r * (q + 1) + (xcd - r) * q) + off; }
        const int nig = WGM * nN, gid = wgid / nig, fm = gid * WGM, gsz = (nM - fm) < WGM ? (nM - fm) : WGM;
        u.pm = fm + ((wgid % nig) % gsz); u.pn = (wgid % nig) / gsz; return true;
    }
};

template <class Epi>
__device__ __forceinline__ void gemm_phase(LAS unsigned char* lds, const Gemm g, const StaticOrder& S, const Epi& E, int tid_in) {
    int tid_ = tid_in; asm volatile("" : "+v"(tid_));
    const int tid = tid_, wid = __builtin_amdgcn_readfirstlane(tid >> 6), lane = tid & 63, wr = wid >> 2, wc = wid & 3, fr = lane & 15, fq = lane >> 4;
    const int K = g.K, nt = K / BK;
    unsigned voffA[2], voffB[2];
#pragma unroll
    for (int i = 0; i < 2; ++i) { int R, C; stage_rc(tid * 16 + i * 8192, R, C); const int Rb = Epi::PERM ? ((R & ~31) + perm32(R & 31)) : R;
        voffA[i] = (unsigned)(R * K + C) * 2u; voffB[i] = (unsigned)(Rb * K + C) * 2u; }
    const size_t kstep = (size_t)(BK * 2);
    const size_t hstep = (size_t)HALF * K * 2;
    const size_t tstep = 2 * hstep;
    const unsigned ldsw = (unsigned)wid * 1024u;
    const int aoff = lds_byte(wr * 64 + fr, fq * 8), boff = lds_byte(wc * 32 + fr, fq * 8);
#define PG8_SA(b, h) (((b) * 2 + (h)) * HTB)
#define PG8_SB(b, h) ((4 + (b) * 2 + (h)) * HTB)
#define PG8_STAGE(bufoff, gbase, voff) do { const char* gb_ = (const char*)(gbase); asm volatile("" : "+s"(gb_));   \
        _Pragma("unroll") for (int _i = 0; _i < 2; ++_i) \
        __builtin_amdgcn_global_load_lds((const unsigned*)(gb_ + (voff)[_i]), (LAS unsigned*)(lds + (bufoff) + ldsw + _i * 8192), 16, 0, 0); } while (0)
#define PG8_LDA(dst, b, h) do { _Pragma("unroll") for (int m = 0; m < 4; ++m) _Pragma("unroll") for (int k = 0; k < 2; ++k) dst[m][k] = *(const LAS bf16x8*)(lds + PG8_SA(b, h) + aoff + m * 2048 + k * 1024); } while (0)
#define PG8_LDB(dst, b, h) do { _Pragma("unroll") for (int n = 0; n < 2; ++n) _Pragma("unroll") for (int k = 0; k < 2; ++k) dst[n][k] = *(const LAS bf16x8*)(lds + PG8_SB(b, h) + boff + n * 2048 + k * 1024); } while (0)
#define PG8_MMA(ai, bj, At, Bt) do { __builtin_amdgcn_s_setprio(1); _Pragma("unroll") for (int m = 0; m < 4; ++m) _Pragma("unroll") for (int n = 0; n < 2; ++n) _Pragma("unroll") for (int k = 0; k < 2; ++k) \
        acc[ai][bj][m][n] = Epi::SWAP ? __builtin_amdgcn_mfma_f32_16x16x32_bf16(At[m][k], Bt[n][k], acc[ai][bj][m][n], 0, 0, 0) \
                                      : __builtin_amdgcn_mfma_f32_16x16x32_bf16(Bt[n][k], At[m][k], acc[ai][bj][m][n], 0, 0, 0); __builtin_amdgcn_s_setprio(0); } while (0)
#define PG8_WAIT_V(n) asm volatile("s_waitcnt vmcnt(" #n ")" ::: "memory")
#define PG8_WAIT_L(n) asm volatile("s_waitcnt lgkmcnt(" #n ")" ::: "memory")
#define PG8_BAR __builtin_amdgcn_s_barrier()
#define PG8_SCHED __builtin_amdgcn_sched_barrier(0)
    Unit cur, nxt; int ui = 0;
    if (!S.next(0, cur)) return;
    f32x4 acc[2][2][4][2];
#pragma unroll
    for (int a = 0; a < 2; ++a)
#pragma unroll
        for (int b = 0; b < 2; ++b)
#pragma unroll
            for (int m = 0; m < 4; ++m)
#pragma unroll
                for (int n = 0; n < 2; ++n) acc[a][b][m][n] = (f32x4){0.f, 0.f, 0.f, 0.f};
    bf16x8 At[4][2], B0[2][2], B1[2][2];
    const char* cA = (const char*)g.A + (size_t)cur.pm * tstep + (size_t)cur.pn * g.acol * 2; const char* cB = (const char*)g.Bt + (size_t)cur.pn * tstep;
    PG8_STAGE(PG8_SB(0, 0), cB, voffB); PG8_STAGE(PG8_SB(0, 1), cB + hstep, voffB); PG8_STAGE(PG8_SA(0, 0), cA, voffA); PG8_STAGE(PG8_SA(0, 1), cA + hstep, voffA);
    if (wr == 1) PG8_BAR;
    PG8_WAIT_V(2); PG8_BAR;
    PG8_STAGE(PG8_SB(1, 0), cB + kstep, voffB); PG8_STAGE(PG8_SA(1, 0), cA + kstep, voffA); PG8_STAGE(PG8_SB(1, 1), cB + hstep + kstep, voffB);
    PG8_WAIT_V(6); PG8_BAR;
    for (;;) {
        const bool has_next = S.next(ui + 1, nxt);
        const char* nA = has_next ? (const char*)g.A + (size_t)nxt.pm * tstep + (size_t)nxt.pn * g.acol * 2 : cA; const char* nB = has_next ? (const char*)g.Bt + (size_t)nxt.pn * tstep : cB;
        for (int t = 0; t < nt; t += 2) {
            const bool last = (t == nt - 2);
            const char* a1 = cA + (size_t)(t + 1) * kstep;
            const char* a2 = last ? nA : cA + (size_t)(t + 2) * kstep; const char* b2 = last ? nB : cB + (size_t)(t + 2) * kstep;
            const char* a3 = a2 + kstep; const char* b3 = b2 + kstep;
            PG8_LDB(B0, 0, 0); PG8_LDB(B1, 0, 1); PG8_SCHED; PG8_LDA(At, 0, 0); PG8_STAGE(PG8_SA(1, 1), a1 + hstep, voffA);
            PG8_WAIT_V(8); PG8_WAIT_L(0); PG8_BAR; PG8_MMA(0, 0, At, B0); PG8_MMA(0, 1, At, B1); PG8_BAR; PG8_SCHED;
            PG8_LDA(At, 0, 1); PG8_STAGE(PG8_SB(0, 0), b2, voffB); PG8_STAGE(PG8_SB(0, 1), b2 + hstep, voffB); PG8_STAGE(PG8_SA(0, 0), a2, voffA);
            PG8_WAIT_V(8); PG8_WAIT_L(0); PG8_BAR; PG8_MMA(1, 0, At, B0); PG8_MMA(1, 1, At, B1); PG8_BAR; PG8_SCHED;
            PG8_LDB(B0, 1, 0); PG8_LDB(B1, 1, 1); PG8_SCHED; PG8_LDA(At, 1, 0); PG8_STAGE(PG8_SA(0, 1), a2 + hstep, voffA);
            PG8_WAIT_V(8); PG8_WAIT_L(0); PG8_BAR; PG8_MMA(0, 0, At, B0); PG8_MMA(0, 1, At, B1); PG8_BAR; PG8_SCHED;
            PG8_LDA(At, 1, 1); PG8_STAGE(PG8_SB(1, 0), b3, voffB); PG8_STAGE(PG8_SB(1, 1), b3 + hstep, voffB); PG8_STAGE(PG8_SA(1, 0), a3, voffA);
            PG8_WAIT_V(8); PG8_WAIT_L(0); PG8_BAR; PG8_MMA(1, 0, At, B0); PG8_MMA(1, 1, At, B1); PG8_BAR; PG8_SCHED;
        }
        if (wr == 0) PG8_BAR;
        const int lane2 = lane_id_fresh();
        E(acc, cur, wr, wc, lane2 & 15, lane2 >> 4);
        if (!has_next) break;
        { int t2 = wid * 64 + lane_id_fresh();
#pragma unroll
          for (int i = 0; i < 2; ++i) { int R, C; stage_rc(t2 * 16 + i * 8192, R, C); const int Rb = Epi::PERM ? ((R & ~31) + perm32(R & 31)) : R;
              voffA[i] = (unsigned)(R * K + C) * 2u; voffB[i] = (unsigned)(Rb * K + C) * 2u; } }
#pragma unroll
        for (int a = 0; a < 2; ++a)
#pragma unroll
            for (int b = 0; b < 2; ++b)
#pragma unroll
                for (int m = 0; m < 4; ++m)
#pragma unroll
                    for (int n = 0; n < 2; ++n) acc[a][b][m][n] = (f32x4){0.f, 0.f, 0.f, 0.f};
        cur = nxt; cA = nA; cB = nB; ++ui;
        if (wr == 1) PG8_BAR;
    }
    PG8_WAIT_V(0);
    PG8_BAR;
#undef PG8_SA
#undef PG8_SB
#undef PG8_STAGE
#undef PG8_LDA
#undef PG8_LDB
#undef PG8_MMA
#undef PG8_WAIT_V
#undef PG8_WAIT_L
#undef PG8_BAR
#undef PG8_SCHED
}
}

enum { EP_QO = 0, EP_KV, EP_RES, EP_GATE, EP_SQRELU, EP_BF16, EP_F32SCALE, EP_RES32, EP_BF16S };
struct EpiArgs {
    const float* ss_in;
    const float* res32;
    const bf16_t* res16;
    bf16_t* xbo;
    float* ss_out;
    const float* bias;
    const bf16_t* pe;
    bf16_t* o16; int ldc;
    float* o32;
    bf16_t *qb, *kb, *kt, *vt, *so; float* gates;
};
template <int MODE> struct Epi {
    static constexpr bool PERM = (MODE != EP_KV), SWAP = (MODE == EP_KV);
    EpiArgs a;
    __device__ __forceinline__ void operator()(const f32x4 (&acc)[2][2][4][2], const pg8::Unit& u, int wr, int wc, int fr_, int fq_) const {
        int fr = fr_, fq = fq_; asm volatile("" : "+v"(fr), "+v"(fq));
        if constexpr (MODE == EP_KV) {
            f32x4 s4v[2][4];
#pragma unroll
            for (int ai = 0; ai < 2; ++ai)
#pragma unroll
                for (int m = 0; m < 4; ++m) s4v[ai][m] = *(const f32x4*)(a.ss_in + u.pm * 256 + ai * 128 + wr * 64 + m * 16 + 4 * fq);
#pragma unroll
            for (int ai = 0; ai < 2; ++ai)
#pragma unroll
                for (int m = 0; m < 4; ++m) {
                    const int row0 = u.pm * 256 + ai * 128 + wr * 64 + m * 16 + 4 * fq;
                    const f32x4 s4 = s4v[ai][m];
                    f32x4 r4; r4.x = rsqrtf(s4.x * (1.f / DM) + EPS); r4.y = rsqrtf(s4.y * (1.f / DM) + EPS); r4.z = rsqrtf(s4.z * (1.f / DM) + EPS); r4.w = rsqrtf(s4.w * (1.f / DM) + EPS);
                    const int b = row0 >> 13, tok = row0 & 8191;
#pragma unroll
                    for (int bj = 0; bj < 2; ++bj)
#pragma unroll
                        for (int n = 0; n < 2; ++n) {
                            const int col = u.pn * 256 + bj * 128 + wc * 32 + 16 * n + fr;
                            const f32x4 v = acc[ai][bj][m][n] * r4;
                            u32x2 w; w.x = cvt_pk_bf16(v.x, v.y); w.y = cvt_pk_bf16(v.z, v.w);
                            if (u.pn < 2) {
                                const int hd = col >> 7, dk = col & 127;
                                *(u32x2*)(a.kt + ((size_t)((b * NH + hd) * DK + dk)) * SEQ + tok) = w;
                                bf16_t* kr = a.kb + (size_t)row0 * 512 + col;
                                kr[0] = (bf16_t)(w.x & 0xffff); kr[512] = (bf16_t)(w.x >> 16); kr[1024] = (bf16_t)(w.y & 0xffff); kr[1536] = (bf16_t)(w.y >> 16);
                            } else {
                                const int vc = col - 512, hd = vc >> 8, dv = vc & 255;
                                *(u32x2*)(a.vt + ((size_t)((b * NH + hd) * DV + dv)) * SEQ + tok) = w;
                            }
                        }
                }
        } else {
            const int rowb = u.pm * 256 + wr * 64 + fr, colb = u.pn * 256 + wc * 32 + 8 * fq;
            constexpr bool USE_SS = (MODE == EP_QO || MODE == EP_GATE || MODE == EP_SQRELU || MODE == EP_F32SCALE || MODE == EP_BF16S);
            constexpr bool IS_RES = (MODE == EP_RES || MODE == EP_RES32 || MODE == EP_GATE);
            constexpr int MB = (MODE == EP_RES32 || MODE == EP_GATE) ? 2 : 4;
            f32x4 gb[2][2];
            if constexpr (MODE == EP_GATE) {
#pragma unroll
                for (int bj = 0; bj < 2; ++bj) { gb[bj][0] = *(const f32x4*)(a.bias + colb + bj * 128); gb[bj][1] = *(const f32x4*)(a.bias + colb + bj * 128 + 4); } }
#pragma unroll
            for (int ai = 0; ai < 2; ++ai)
#pragma unroll
              for (int mb = 0; mb < 4; mb += MB) {
                float ssv[MB]; u32x4 rw[MB][2]; f32x4 r32[MB][2][2]; u32x4 pwv[MB][2];
#pragma unroll
                for (int mm = 0; mm < MB; ++mm) { const int row = rowb + ai * 128 + (mb + mm) * 16;
                    if constexpr (USE_SS) ssv[mm] = a.ss_in[row];
#pragma unroll
                    for (int bj = 0; bj < 2; ++bj) { const size_t off = (size_t)row * DM + colb + bj * 128;
                        if constexpr (MODE == EP_RES32) { r32[mm][bj][0] = *(const f32x4*)(a.res32 + off); r32[mm][bj][1] = *(const f32x4*)(a.res32 + off + 4); }
                        if constexpr (MODE == EP_RES || MODE == EP_GATE) rw[mm][bj] = *(const u32x4*)(a.res16 + off);
                        if constexpr (MODE == EP_GATE) pwv[mm][bj] = *(const u32x4*)(a.pe + off); } }
#pragma unroll
                for (int mm = 0; mm < MB; ++mm) {
                    const int m = mb + mm;
                    const int row = rowb + ai * 128 + m * 16;
                    float rs = 1.f;
                    if constexpr (USE_SS) rs = rsqrtf(ssv[mm] * (1.f / DM) + EPS);
                    float ssq = 0.f;
#pragma unroll
                    for (int bj = 0; bj < 2; ++bj) {
                        const int col = colb + bj * 128;
                        f32x4 v0 = acc[ai][bj][m][0] * rs, v1 = acc[ai][bj][m][1] * rs;
                        if constexpr (MODE == EP_QO) {
                            if (u.pn < 2) {
                                u32x4 w; w.x = cvt_pk_bf16(v0.x, v0.y); w.y = cvt_pk_bf16(v0.z, v0.w); w.z = cvt_pk_bf16(v1.x, v1.y); w.w = cvt_pk_bf16(v1.z, v1.w);
                                *(u32x4*)(a.qb + (size_t)row * 512 + col) = w;
                            } else if (u.pn < 6) {
                                u32x4 w; w.x = cvt_pk_bf16(sigmoidf_(v0.x), sigmoidf_(v0.y)); w.y = cvt_pk_bf16(sigmoidf_(v0.z), sigmoidf_(v0.w));
                                w.z = cvt_pk_bf16(sigmoidf_(v1.x), sigmoidf_(v1.y)); w.w = cvt_pk_bf16(sigmoidf_(v1.z), sigmoidf_(v1.w));
                                *(u32x4*)(a.so + (size_t)row * 1024 + (col - 512)) = w;
                            }
                        } else if constexpr (MODE == EP_SQRELU) {
                            v0.x = fmaxf(v0.x, 0.f); v0.y = fmaxf(v0.y, 0.f); v0.z = fmaxf(v0.z, 0.f); v0.w = fmaxf(v0.w, 0.f);
                            v1.x = fmaxf(v1.x, 0.f); v1.y = fmaxf(v1.y, 0.f); v1.z = fmaxf(v1.z, 0.f); v1.w = fmaxf(v1.w, 0.f);
                            v0 = v0 * v0; v1 = v1 * v1;
                            u32x4 w; w.x = cvt_pk_bf16(v0.x, v0.y); w.y = cvt_pk_bf16(v0.z, v0.w); w.z = cvt_pk_bf16(v1.x, v1.y); w.w = cvt_pk_bf16(v1.z, v1.w);
                            *(u32x4*)(a.o16 + (size_t)row * a.ldc + col) = w;
                        } else if constexpr (MODE == EP_BF16 || MODE == EP_BF16S) {
                            u32x4 w; w.x = cvt_pk_bf16(v0.x, v0.y); w.y = cvt_pk_bf16(v0.z, v0.w); w.z = cvt_pk_bf16(v1.x, v1.y); w.w = cvt_pk_bf16(v1.z, v1.w);
                            *(u32x4*)(a.o16 + (size_t)row * a.ldc + col) = w;
                        } else if constexpr (MODE == EP_F32SCALE) {
                            *(f32x4*)(a.o32 + (size_t)row * DM + col) = v0; *(f32x4*)(a.o32 + (size_t)row * DM + col + 4) = v1;
                        } else {
                            const size_t off = (size_t)row * DM + col;
                            f32x4 r0, r1;
                            if constexpr (MODE == EP_RES32) { r0 = r32[mm][bj][0]; r1 = r32[mm][bj][1]; }
                            else { const u32x4 rq = rw[mm][bj]; r0 = (f32x4){bf_lo(rq.x), bf_hi(rq.x), bf_lo(rq.y), bf_hi(rq.y)}; r1 = (f32x4){bf_lo(rq.z), bf_hi(rq.z), bf_lo(rq.w), bf_hi(rq.w)}; }
                            if constexpr (MODE == EP_GATE) {
                                const f32x4 b0 = gb[bj][0], b1 = gb[bj][1];
                                const u32x4 pw = pwv[mm][bj];
                                v0 = v0 + b0; v1 = v1 + b1;
                                v0.x = sigmoidf_(v0.x) * bf_lo(pw.x); v0.y = sigmoidf_(v0.y) * bf_hi(pw.x); v0.z = sigmoidf_(v0.z) * bf_lo(pw.y); v0.w = sigmoidf_(v0.w) * bf_hi(pw.y);
                                v1.x = sigmoidf_(v1.x) * bf_lo(pw.z); v1.y = sigmoidf_(v1.y) * bf_hi(pw.z); v1.z = sigmoidf_(v1.z) * bf_lo(pw.w); v1.w = sigmoidf_(v1.w) * bf_hi(pw.w);
                            }
                            v0 = v0 + r0; v1 = v1 + r1;
                            u32x4 w; w.x = cvt_pk_bf16(v0.x, v0.y); w.y = cvt_pk_bf16(v0.z, v0.w); w.z = cvt_pk_bf16(v1.x, v1.y); w.w = cvt_pk_bf16(v1.z, v1.w);
                            *(u32x4*)(a.xbo + off) = w;
                            v0 = (f32x4){bf_lo(w.x), bf_hi(w.x), bf_lo(w.y), bf_hi(w.y)}; v1 = (f32x4){bf_lo(w.z), bf_hi(w.z), bf_lo(w.w), bf_hi(w.w)};
                            ssq += (v0.x * v0.x + v0.y * v0.y) + (v0.z * v0.z + v0.w * v0.w) + (v1.x * v1.x + v1.y * v1.y) + (v1.z * v1.z + v1.w * v1.w);
                        }
                    }
                    if constexpr (IS_RES) {
                        const int ln_ = fq * 16 + fr; ssq += shx(ssq, 16, ln_); ssq += shx(ssq, 32, ln_);
                        if (fq == 0) atomicAdd(a.ss_out + row, ssq);
                    }
                }
              }
        }
    }
};

struct Args { const float* in[19]; float* out; unsigned char* ws; int ph_lo, ph_hi; };
struct Frame {
    LAS unsigned char* lds; int tid, lane, wave, G, bid;
    unsigned char* ws; float* out;
};

__device__ __forceinline__ float wave_sum(float v, int lane) {
#pragma unroll
    for (int o = 1; o < 64; o <<= 1) v += shx(v, o, lane);
    return v;
}

__device__ __forceinline__ void transpose_item(const float* W, int N, int k0, int n0, bf16_t* WT, int ldt, int drow0, const float* kgain, const float* ngain, float scale, LAS float* scr, int lane) {
    const int nn = n0 + (lane & 31);
    float v[32];
#pragma unroll
    for (int i = 0; i < 32; ++i) v[i] = (nn < N) ? W[(size_t)(k0 + 2 * i + (lane >> 5)) * N + nn] : 0.f;
#pragma unroll
    for (int i = 0; i < 32; ++i) scr[(2 * i + (lane >> 5)) * 33 + (lane & 31)] = v[i];
    asm volatile("s_waitcnt lgkmcnt(0)" ::: "memory");
    const int c = lane & 7;
    f32x4 g0 = {1.f, 1.f, 1.f, 1.f}, g1 = g0;
    if (kgain) { g0 = *(const f32x4*)(kgain + k0 + 8 * c); g1 = *(const f32x4*)(kgain + k0 + 8 * c + 4); }
#pragma unroll
    for (int j = 0; j < 4; ++j) { const int n = (lane >> 3) + 8 * j; const LAS float* s = scr + (8 * c) * 33 + n;
        float sc = scale; if (ngain) sc *= ngain[n0 + n];
        u32x4 o; o.x = cvt_pk_bf16(s[0 * 33] * sc * g0.x, s[1 * 33] * sc * g0.y); o.y = cvt_pk_bf16(s[2 * 33] * sc * g0.z, s[3 * 33] * sc * g0.w);
        o.z = cvt_pk_bf16(s[4 * 33] * sc * g1.x, s[5 * 33] * sc * g1.y); o.w = cvt_pk_bf16(s[6 * 33] * sc * g1.z, s[7 * 33] * sc * g1.w);
        *(u32x4*)(WT + (size_t)(drow0 + n) * ldt + k0 + 8 * c) = o; }
    asm volatile("s_waitcnt lgkmcnt(0)" ::: "memory");
}

__device__ __forceinline__ void p0_prologue(const Frame& F, const Args& A) {
    LAS float* scr = (LAS float*)(F.lds + F.wave * 16384);
    const int gw = F.bid * 8 + F.wave, NGW = F.G * 8;
    bf16_t* WB = (bf16_t*)(F.ws + WS_W);
    const float* norm_mix = A.in[2]; const float* norm_mlp = A.in[3]; const float* norm_ple = A.in[4];
    constexpr int I_WIN = 16 * 97, I_SQ = 16 * 32, I_GRP = 4 * 4 * 8, I_W1 = 16 * 128, I_W2 = 64 * 32, I_PLE = 4 * 32;
    constexpr int NITEMS = I_WIN + 3 * I_SQ + I_GRP + 2 * I_W1 + 2 * I_W2 + 2 * I_PLE + 2 * I_SQ;
    for (int it = gw; it < NITEMS; it += NGW) {
        int r = it;
        if (r < I_WIN) {
            const int kb = r / 97, nb = r % 97, n0 = nb * 32; int drow; float sc = 1.f;
            if (n0 < 512) drow = n0; else if (n0 < 1024) { drow = NA + (n0 - 512); sc = 0.08838834764831845f; } else if (n0 < 2048) drow = NA + 512 + (n0 - 1024); else if (n0 < 3072) drow = 512 + (n0 - 2048); else drow = 1536 + (n0 - 3072);
            transpose_item(A.in[6], WIN_N, kb * 64, n0, WB + WO_WIN, 1024, drow, norm_mix, nullptr, sc, scr, F.lane); continue; }
        r -= I_WIN;
        if (r < I_SQ) { transpose_item(A.in[9], 1024, (r / 32) * 64, (r % 32) * 32, WB + WO_WOUT, 1024, (r % 32) * 32, nullptr, nullptr, 1.f, scr, F.lane); continue; }
        r -= I_SQ;
        if (r < I_SQ) { transpose_item(A.in[10], 1024, (r / 32) * 64, (r % 32) * 32, WB + WO_PIN, 1024, (r % 32) * 32, norm_mix + DM, nullptr, 1.f, scr, F.lane); continue; }
        r -= I_SQ;
        if (r < I_GRP) { const int g = r / 32, q = r % 32;
            transpose_item(A.in[11] + (size_t)g * 65536, 256, (q / 8) * 64, (q % 8) * 32, WB + WO_GRP, 256, g * 256 + (q % 8) * 32, nullptr, A.in[12] + g * 256, 1.f, scr, F.lane); continue; }
        r -= I_GRP;
        if (r < I_SQ) { transpose_item(A.in[13], 1024, (r / 32) * 64, (r % 32) * 32, WB + WO_POUT, 1024, (r % 32) * 32, nullptr, nullptr, 1.f, scr, F.lane); continue; }
        r -= I_SQ;
        if (r < 2 * I_W1) { const int l = r / I_W1, q = r % I_W1;
            transpose_item(A.in[14] + (size_t)l * 1024 * 4096, 4096, (q / 128) * 64, (q % 128) * 32, WB + WO_W1 + (size_t)l * 4096 * 1024, 1024, (q % 128) * 32, norm_mlp + l * DM, nullptr, 1.f, scr, F.lane); continue; }
        r -= 2 * I_W1;
        if (r < 2 * I_W2) { const int l = r / I_W2, q = r % I_W2;
            transpose_item(A.in[15] + (size_t)l * 1024 * 4096, 1024, (q / 32) * 64, (q % 32) * 32, WB + WO_W2 + (size_t)l * 4096 * 1024, 4096, (q % 32) * 32, nullptr, nullptr, 1.f, scr, F.lane); continue; }
        r -= 2 * I_W2;
        if (r < 2 * I_PLE) { const int l = r / I_PLE, q = r % I_PLE;
            transpose_item(A.in[16] + (size_t)l * 256 * 1024, 1024, (q / 32) * 64, (q % 32) * 32, WB + WO_PLE + (size_t)l * 1024 * 256, 256, (q % 32) * 32, nullptr, nullptr, 1.f, scr, F.lane); continue; }
        r -= 2 * I_PLE;
        { const int l = r / I_SQ, q = r % I_SQ;
            transpose_item(A.in[17] + (size_t)l * 1024 * 1024, 1024, (q / 32) * 64, (q % 32) * 32, WB + WO_GATE + (size_t)l * 1024 * 1024, 1024, (q % 32) * 32, norm_ple + l * DM, nullptr, 1.f, scr, F.lane); }
    }
    const int gt = F.bid * 512 + F.tid, NGT = F.G * 512;
    { u32x4* z = (u32x4*)(WB + WO_WIN + (size_t)1568 * 1024); const u32x4 zz = {0u, 0u, 0u, 0u};
      for (int i = gt; i < 224 * 1024 / 8; i += NGT) z[i] = zz; }
    { f32x4* z = (f32x4*)(F.ws + WS_SS) + M / 4; const f32x4 zz = {0.f, 0.f, 0.f, 0.f};
      for (int i = gt; i < 6 * M / 4; i += NGT) z[i] = zz; }
    { const float* x = A.in[0]; bf16_t* XB = (bf16_t*)(F.ws + WS_XB); float* SS = (float*)(F.ws + WS_SS);
      for (int m0 = gw * 4; m0 < M; m0 += NGW * 4) {
          f32x4 v[4][4];
#pragma unroll
          for (int r = 0; r < 4; ++r) { const f32x4* xr = (const f32x4*)(x + (size_t)(m0 + r) * DM) + F.lane;
#pragma unroll
              for (int j = 0; j < 4; ++j) v[r][j] = xr[64 * j]; }
#pragma unroll
          for (int r = 0; r < 4; ++r) { float s = 0.f;
#pragma unroll
              for (int j = 0; j < 4; ++j) s += (v[r][j].x * v[r][j].x + v[r][j].y * v[r][j].y) + (v[r][j].z * v[r][j].z + v[r][j].w * v[r][j].w);
              s = wave_sum(s, F.lane);
              u32x2* o8 = (u32x2*)(XB + (size_t)(m0 + r) * DM) + F.lane;
#pragma unroll
              for (int j = 0; j < 4; ++j) { u32x2 w; w.x = cvt_pk_bf16(v[r][j].x, v[r][j].y); w.y = cvt_pk_bf16(v[r][j].z, v[r][j].w); o8[64 * j] = w; }
              if (F.lane == 0) SS[m0 + r] = s; } } }
    { const f32x4* p = (const f32x4*)A.in[1]; u32x2* o = (u32x2*)(F.ws + WS_PB);
      for (int i = gt; i < 2 * M * PLE / 4; i += NGT * 8) { f32x4 v[8];
#pragma unroll
          for (int j = 0; j < 8; ++j) v[j] = (i + j * NGT < 2 * M * PLE / 4) ? p[i + j * NGT] : (f32x4){0.f, 0.f, 0.f, 0.f};
#pragma unroll
          for (int j = 0; j < 8; ++j) if (i + j * NGT < 2 * M * PLE / 4) { u32x2 w; w.x = cvt_pk_bf16(v[j].x, v[j].y); w.y = cvt_pk_bf16(v[j].z, v[j].w); o[i + j * NGT] = w; } } }
}

__device__ __forceinline__ float logsigmoidf_(float f) { return fminf(f, 0.f) - __logf(1.f + __expf(-fabsf(f))); }
__device__ __forceinline__ void mlstm_scan(const Frame& F, float* cst_base  ) {
    LAS float* Bc = (LAS float*)(F.lds);
    LAS float* Gc = Bc + 8192; LAS float* Pc = Gc + 8192; LAS float* Wc = Pc + 8192;
    LAS float* BL = Wc + 8192; LAS float* ML = BL + 64; LAS float* MC = ML + 64; LAS float* DEC = MC + 68;
    const float* GATES = (const float*)(F.ws + WS_GATES);
    float* TOKV = (float*)(F.ws + WS_TOKV);
    const bf16_t* KT = (const bf16_t*)(F.ws + WS_KT); const bf16_t* VT = (const bf16_t*)(F.ws + WS_VT);
    bf16_t* CST = (bf16_t*)cst_base; float* NST = (float*)(F.ws + WS_NST);
    const int lane = F.lane, wave = F.wave, fr = lane & 15, fq = lane >> 4;
    const int vb = (F.G % 8 == 0) ? (F.bid & 7) * (F.G >> 3) + (F.bid >> 3) : F.bid;
    for (int u = vb; u < 256; u += F.G) {
        const int dvs = u & 7, dir = (u >> 3) & 1, h = (u >> 4) & 3, b = u >> 6;
        const int icol = dir * 8 + h, fcol = dir * 8 + 4 + h;
        const float* gp = GATES + (size_t)b * SEQ * 16;
        for (int cc = wave; cc < NCH; cc += 8) {
            const int oc = dir ? (NCH - 1 - cc) : cc;
            const int p0 = 2 * lane, p1 = p0 + 1, o0 = dir ? 127 - p0 : p0, o1 = dir ? 127 - p1 : p1;
            const float f0 = gp[(size_t)(oc * 128 + o0) * 16 + fcol], i0 = gp[(size_t)(oc * 128 + o0) * 16 + icol];
            const float f1 = gp[(size_t)(oc * 128 + o1) * 16 + fcol], i1 = gp[(size_t)(oc * 128 + o1) * 16 + icol];
            const float a0 = logsigmoidf_(f0), a1 = logsigmoidf_(f1);
            float inc = a0 + a1;
#pragma unroll
            for (int o = 1; o < 64; o <<= 1) { const float t = shup(inc, o, lane); if (lane >= o) inc += t; }
            const float b0 = inc - a1, b1 = inc;
            const float g0 = i0 - b0, g1 = i1 - b1;
            float mx = fmaxf(g0, g1);
#pragma unroll
            for (int o = 1; o < 64; o <<= 1) { const float t = shup(mx, o, lane); if (lane >= o) mx = fmaxf(mx, t); }
            float exm = shup(mx, 1, lane); if (lane == 0) exm = -INFINITY;
            const float pm0 = fmaxf(exm, g0), pm1 = mx;
            Bc[cc * 128 + p0] = b0; Bc[cc * 128 + p1] = b1; Gc[cc * 128 + p0] = g0; Gc[cc * 128 + p1] = g1; Pc[cc * 128 + p0] = pm0; Pc[cc * 128 + p1] = pm1;
            if (lane == 63) { BL[cc] = b1; ML[cc] = b1 + pm1; }
        }
        __syncthreads();
        if (F.tid == 0) { float m = 0.f; MC[0] = 0.f; for (int cc = 0; cc < NCH; ++cc) { const float mn = fmaxf(BL[cc] + m, ML[cc]); DEC[cc] = __expf(BL[cc] + m - mn); m = mn; MC[cc + 1] = m; } }
        __syncthreads();
        for (int idx = F.tid; idx < SEQ; idx += 512) {
            const int cc = idx >> 7, pp = idx & 127, oc = dir ? (NCH - 1 - cc) : cc, o = dir ? 127 - pp : pp;
            const float bb = Bc[idx], g = Gc[idx], pm = Pc[idx], mc = MC[cc], mn = MC[cc + 1];
            Wc[oc * 128 + o] = __expf(BL[cc] + g - mn);
            if (dvs == 0) { const float x1 = -fmaxf(mc, pm); const size_t ti = (size_t)((b * NH + h) * 2 + dir) * SEQ + oc * 128 + o;
                TOKV[ti] = x1; TOKV[(size_t)32 * SEQ + ti] = g; TOKV[(size_t)64 * SEQ + ti] = __expf(x1 - bb); TOKV[(size_t)96 * SEQ + ti] = __expf(mc + x1); }
        }
        __syncthreads();
        const bf16_t* ktp = KT + ((size_t)((b * NH + h) * DK + 16 * wave + fr)) * SEQ + 8 * fq;
        const bf16_t* vdp = VT + ((size_t)((b * NH + h) * DV + 32 * dvs + (lane & 31))) * SEQ + 8 * (2 * wave + (lane >> 5));
        LAS unsigned char* ring = F.lds;
        const int vwo = wave * 1024 + lane * 16;
        const int vro = fr * 16 + fq * 512;
        bf16_t* cso = CST + ((size_t)((b * NH + h) * 2 + dir) * NCH) * DV * DK + (size_t)(32 * dvs + fr) * DK + 16 * wave + 4 * fq;
        float* nso = NST + ((size_t)((b * NH + h) * 2 + dir) * NCH) * DK + 16 * wave + 4 * fq;
        f32x4 c0 = {0.f, 0.f, 0.f, 0.f}, c1 = c0, cn = c0;
        const bf16x8 ones = {0x3F80, 0x3F80, 0x3F80, 0x3F80, 0x3F80, 0x3F80, 0x3F80, 0x3F80};
        u32x4 kr[4][4], vr[4];
#define SCAN_ISSUE(j, cnext) do { const int on_ = dir ? (NCH - 1 - (cnext)) : (cnext); \
            _Pragma("unroll") for (int ks = 0; ks < 4; ++ks) kr[j][ks] = *(const u32x4*)(ktp + on_ * 128 + 32 * ks); \
            vr[j] = *(const u32x4*)(vdp + on_ * 128); } while (0)
        SCAN_ISSUE(0, 0); SCAN_ISSUE(1, 1); SCAN_ISSUE(2, 2); SCAN_ISSUE(3, 3);
#define SCAN_STEP(j) do { const int cc = cb + (j); const int oc = dir ? (NCH - 1 - cc) : cc; \
            u32x4 kc[4]; _Pragma("unroll") for (int ks = 0; ks < 4; ++ks) kc[ks] = kr[j][ks]; \
            *(LAS u32x4*)(ring + (cc & 1) * 8192 + vwo) = vr[j]; \
            asm volatile("s_waitcnt lgkmcnt(0)" ::: "memory"); __builtin_amdgcn_s_barrier(); asm volatile("" ::: "memory"); \
            if (cc + 4 < NCH) SCAN_ISSUE(j, cc + 4); \
            { u32x2 w0_, w1_; w0_.x = cvt_pk_bf16(c0.x, c0.y); w0_.y = cvt_pk_bf16(c0.z, c0.w); w1_.x = cvt_pk_bf16(c1.x, c1.y); w1_.y = cvt_pk_bf16(c1.z, c1.w); \
              bf16_t* p0_ = cso + (size_t)oc * DV * DK; bf16_t* p1_ = p0_ + 16 * DK; \
              asm volatile("global_store_dwordx2 %0, %1, off\n\tglobal_store_dwordx2 %2, %3, off" :: "v"(p0_), "v"(w0_), "v"(p1_), "v"(w1_) : "memory"); \
              if (dvs == 0 && fr == 0) { float* pn_ = nso + (size_t)oc * DK; asm volatile("s_nop 7\n\ts_nop 7\n\ts_nop 7\n\tglobal_store_dwordx4 %0, %1, off\n\ts_nop 1" :: "v"(pn_), "v"(cn) : "memory"); } } \
            const float dec = DEC[cc]; \
            const LAS unsigned char* vs = ring + (cc & 1) * 8192 + vro; \
            f32x4 wv[4][2]; bf16x8 vf[4][2]; \
            _Pragma("unroll") for (int ks = 0; ks < 4; ++ks) { wv[ks][0] = *(const LAS f32x4*)(Wc + oc * 128 + 32 * ks + 8 * fq); wv[ks][1] = *(const LAS f32x4*)(Wc + oc * 128 + 32 * ks + 8 * fq + 4); \
                vf[ks][0] = *(const LAS bf16x8*)(vs + ks * 2048); vf[ks][1] = *(const LAS bf16x8*)(vs + ks * 2048 + 256); } \
            c0 = c0 * dec; c1 = c1 * dec; cn = cn * dec; \
            _Pragma("unroll") for (int ks = 0; ks < 4; ++ks) { \
                const f32x4 w0 = wv[ks][0], w1 = wv[ks][1]; \
                u32x4 kw; kw.x = cvt_pk_bf16(bf_lo(kc[ks].x) * w0.x, bf_hi(kc[ks].x) * w0.y); kw.y = cvt_pk_bf16(bf_lo(kc[ks].y) * w0.z, bf_hi(kc[ks].y) * w0.w); \
                kw.z = cvt_pk_bf16(bf_lo(kc[ks].z) * w1.x, bf_hi(kc[ks].z) * w1.y); kw.w = cvt_pk_bf16(bf_lo(kc[ks].w) * w1.z, bf_hi(kc[ks].w) * w1.w); \
                const bf16x8 af = __builtin_bit_cast(bf16x8, kw); \
                c0 = __builtin_amdgcn_mfma_f32_16x16x32_bf16(af, vf[ks][0], c0, 0, 0, 0); \
                c1 = __builtin_amdgcn_mfma_f32_16x16x32_bf16(af, vf[ks][1], c1, 0, 0, 0); \
                cn = __builtin_amdgcn_mfma_f32_16x16x32_bf16(af, ones, cn, 0, 0, 0); } } while (0)
#pragma unroll 1
        for (int cb = 0; cb < NCH; cb += 4) { SCAN_STEP(0); SCAN_STEP(1); SCAN_STEP(2); SCAN_STEP(3); }
#undef SCAN_ISSUE
#undef SCAN_STEP
        asm volatile("s_waitcnt vmcnt(0)" ::: "memory");
        __syncthreads();
    }
}

constexpr int PITCH = 272;
__device__ __forceinline__ void mlstm_out(const Frame& F, const float* head_norm, const float* cst_base) {
    LAS unsigned char* PS = F.lds; LAS unsigned char* QF = PS + 128 * PITCH; LAS unsigned char* QBk = QF + 128 * PITCH;
    LAS float* RED = (LAS float*)(QBk + 128 * PITCH);
    const float* TOKV = (const float*)(F.ws + WS_TOKV);
    const bf16_t* QB = (const bf16_t*)(F.ws + WS_QB); const bf16_t* KB = (const bf16_t*)(F.ws + WS_KB); const bf16_t* VT = (const bf16_t*)(F.ws + WS_VT);
    const bf16_t* SO = (const bf16_t*)(F.ws + WS_SO); const bf16_t* CST = (const bf16_t*)cst_base; const float* NST = (const float*)(F.ws + WS_NST);
    bf16_t* HM = (bf16_t*)(F.ws + WS_HM);
    for (int u = F.bid; u < NB * NH * NCH; u += F.G) {
        int lane_ = F.lane, wave_ = F.wave; asm volatile("" : "+v"(lane_), "+s"(wave_));
        const int lane = lane_, wave = wave_, fr = lane & 15, fq = lane >> 4;
        const int oc = u & 63, h = (u >> 6) & 3, b = u >> 8;
        const int tl = oc * 128; const size_t T0 = (size_t)b * SEQ + tl;
        const int bh = b * NH + h;
        bf16x8 Vf[2][4], Cf[2][4], Cb[2][4];
#pragma unroll
        for (int vt = 0; vt < 2; ++vt) { const int vrow = 32 * wave + 16 * vt + fr;
#pragma unroll
            for (int ks = 0; ks < 4; ++ks) {
                Vf[vt][ks] = *(const bf16x8*)(VT + ((size_t)(bh * DV + vrow)) * SEQ + tl + 32 * ks + 8 * fq);
                Cf[vt][ks] = *(const bf16x8*)(CST + (((size_t)(bh * 2 + 0) * NCH + oc) * DV + vrow) * DK + 32 * ks + 8 * fq); } }
        const int t = 16 * wave + fr;
        u32x4 Qr[4];
#pragma unroll
        for (int ks = 0; ks < 4; ++ks) Qr[ks] = *(const u32x4*)(QB + (T0 + t) * 512 + h * DK + 32 * ks + 8 * fq);
        f32x4 S[8];
        const bf16_t* kp = KB + (T0 + fr) * 512 + h * DK + 8 * fq;
#pragma unroll
        for (int st = 0; st < 8; ++st) { S[st] = (f32x4){0.f, 0.f, 0.f, 0.f};
            asm volatile("" : "+v"(kp));
#pragma unroll
            for (int ks = 0; ks < 4; ++ks) { const bf16x8 kf = *(const bf16x8*)(kp + 32 * ks);
                S[st] = __builtin_amdgcn_mfma_f32_16x16x32_bf16(kf, __builtin_bit_cast(bf16x8, Qr[ks]), S[st], 0, 0, 0); }
            kp += 16 * 512; }
        const size_t gf = (size_t)(bh * 2 + 0) * SEQ + tl, gb = (size_t)(bh * 2 + 1) * SEQ + tl;
        const float x1f = TOKV[gf + t], emf = TOKV[(size_t)64 * SEQ + gf + t], inf_ = TOKV[(size_t)96 * SEQ + gf + t];
        const float x1b = TOKV[gb + t], emb = TOKV[(size_t)64 * SEQ + gb + t], inb_ = TOKV[(size_t)96 * SEQ + gb + t];
        float sumf = 0.f, sumb = 0.f;
#pragma unroll
        for (int st = 0; st < 8; ++st) {
            const f32x4 g4f = *(const f32x4*)(TOKV + (size_t)32 * SEQ + gf + 16 * st + 4 * fq), g4b = *(const f32x4*)(TOKV + (size_t)32 * SEQ + gb + 16 * st + 4 * fq);
            const int s0 = 16 * st + 4 * fq;
            f32x4 pf, pb;
            pf.x = (s0 + 0 <= t) ? S[st].x * __expf(x1f + g4f.x) : 0.f; pf.y = (s0 + 1 <= t) ? S[st].y * __expf(x1f + g4f.y) : 0.f;
            pf.z = (s0 + 2 <= t) ? S[st].z * __expf(x1f + g4f.z) : 0.f; pf.w = (s0 + 3 <= t) ? S[st].w * __expf(x1f + g4f.w) : 0.f;
            pb.x = (s0 + 0 >= t) ? S[st].x * __expf(x1b + g4b.x) : 0.f; pb.y = (s0 + 1 >= t) ? S[st].y * __expf(x1b + g4b.y) : 0.f;
            pb.z = (s0 + 2 >= t) ? S[st].z * __expf(x1b + g4b.z) : 0.f; pb.w = (s0 + 3 >= t) ? S[st].w * __expf(x1b + g4b.w) : 0.f;
            sumf += (pf.x + pf.y) + (pf.z + pf.w); sumb += (pb.x + pb.y) + (pb.z + pb.w);
        }
        float qnf = 0.f, qnb = 0.f;
        const float* nf = NST + ((size_t)(bh * 2 + 0) * NCH + oc) * DK; const float* nb = NST + ((size_t)(bh * 2 + 1) * NCH + oc) * DK;
#pragma unroll
        for (int ks = 0; ks < 4; ++ks) {
            const f32x4 a0 = *(const f32x4*)(nf + 32 * ks + 8 * fq), a1 = *(const f32x4*)(nf + 32 * ks + 8 * fq + 4), b0 = *(const f32x4*)(nb + 32 * ks + 8 * fq), b1 = *(const f32x4*)(nb + 32 * ks + 8 * fq + 4);
            const float q0 = bf_lo(Qr[ks].x), q1 = bf_hi(Qr[ks].x), q2 = bf_lo(Qr[ks].y), q3 = bf_hi(Qr[ks].y), q4 = bf_lo(Qr[ks].z), q5 = bf_hi(Qr[ks].z), q6 = bf_lo(Qr[ks].w), q7 = bf_hi(Qr[ks].w);
            qnf += (q0 * a0.x + q1 * a0.y) + (q2 * a0.z + q3 * a0.w) + (q4 * a1.x + q5 * a1.y) + (q6 * a1.z + q7 * a1.w);
            qnb += (q0 * b0.x + q1 * b0.y) + (q2 * b0.z + q3 * b0.w) + (q4 * b1.x + q5 * b1.y) + (q6 * b1.z + q7 * b1.w);
        }
        sumf += shx(sumf, 16, lane); sumf += shx(sumf, 32, lane); sumb += shx(sumb, 16, lane); sumb += shx(sumb, 32, lane);
        qnf += shx(qnf, 16, lane); qnf += shx(qnf, 32, lane); qnb += shx(qnb, 16, lane); qnb += shx(qnb, 32, lane);
        const float rdf = 1.0f / fmaxf(fabsf(sumf + inf_ * qnf), emf), rdb = 1.0f / fmaxf(fabsf(sumb + inb_ * qnb), emb);
        asm volatile("" ::: "memory");
#pragma unroll
        for (int st = 0; st < 8; ++st) {
            const f32x4 g4f = *(const f32x4*)(TOKV + (size_t)32 * SEQ + gf + 16 * st + 4 * fq), g4b = *(const f32x4*)(TOKV + (size_t)32 * SEQ + gb + 16 * st + 4 * fq);
            const int s0 = 16 * st + 4 * fq;
            f32x4 p;
            p.x = S[st].x * (((s0 + 0 <= t) ? __expf(x1f + g4f.x) * rdf : 0.f) + ((s0 + 0 >= t) ? __expf(x1b + g4b.x) * rdb : 0.f));
            p.y = S[st].y * (((s0 + 1 <= t) ? __expf(x1f + g4f.y) * rdf : 0.f) + ((s0 + 1 >= t) ? __expf(x1b + g4b.y) * rdb : 0.f));
            p.z = S[st].z * (((s0 + 2 <= t) ? __expf(x1f + g4f.z) * rdf : 0.f) + ((s0 + 2 >= t) ? __expf(x1b + g4b.z) * rdb : 0.f));
            p.w = S[st].w * (((s0 + 3 <= t) ? __expf(x1f + g4f.w) * rdf : 0.f) + ((s0 + 3 >= t) ? __expf(x1b + g4b.w) * rdb : 0.f));
            u32x2 w; w.x = cvt_pk_bf16(p.x, p.y); w.y = cvt_pk_bf16(p.z, p.w);
            *(LAS u32x2*)(PS + t * PITCH + (16 * st + 4 * fq) * 2) = w; }
        { const float sf = inf_ * rdf, sb = inb_ * rdb;
#pragma unroll
          for (int ks = 0; ks < 4; ++ks) {
              const float q0 = bf_lo(Qr[ks].x), q1 = bf_hi(Qr[ks].x), q2 = bf_lo(Qr[ks].y), q3 = bf_hi(Qr[ks].y), q4 = bf_lo(Qr[ks].z), q5 = bf_hi(Qr[ks].z), q6 = bf_lo(Qr[ks].w), q7 = bf_hi(Qr[ks].w);
              u32x4 w; w.x = cvt_pk_bf16(q0 * sf, q1 * sf); w.y = cvt_pk_bf16(q2 * sf, q3 * sf); w.z = cvt_pk_bf16(q4 * sf, q5 * sf); w.w = cvt_pk_bf16(q6 * sf, q7 * sf);
              *(LAS u32x4*)(QF + t * PITCH + (32 * ks + 8 * fq) * 2) = w;
              w.x = cvt_pk_bf16(q0 * sb, q1 * sb); w.y = cvt_pk_bf16(q2 * sb, q3 * sb); w.z = cvt_pk_bf16(q4 * sb, q5 * sb); w.w = cvt_pk_bf16(q6 * sb, q7 * sb);
              *(LAS u32x4*)(QBk + t * PITCH + (32 * ks + 8 * fq) * 2) = w; } }
#pragma unroll
        for (int vt = 0; vt < 2; ++vt) { const int vrow = 32 * wave + 16 * vt + fr;
#pragma unroll
            for (int ks = 0; ks < 4; ++ks) Cb[vt][ks] = *(const bf16x8*)(CST + (((size_t)(bh * 2 + 1) * NCH + oc) * DV + vrow) * DK + 32 * ks + 8 * fq); }
        __syncthreads();
        f32x4 acc[8][2];
#pragma unroll
        for (int tt = 0; tt < 8; ++tt) {
            acc[tt][0] = (f32x4){0.f, 0.f, 0.f, 0.f}; acc[tt][1] = acc[tt][0];
            const int ro = (16 * tt + fr) * PITCH + 16 * fq;
#pragma unroll
            for (int ks = 0; ks < 4; ++ks) { const bf16x8 p = *(const LAS bf16x8*)(PS + ro + 64 * ks);
                acc[tt][0] = __builtin_amdgcn_mfma_f32_16x16x32_bf16(Vf[0][ks], p, acc[tt][0], 0, 0, 0); acc[tt][1] = __builtin_amdgcn_mfma_f32_16x16x32_bf16(Vf[1][ks], p, acc[tt][1], 0, 0, 0); }
#pragma unroll
            for (int ks = 0; ks < 4; ++ks) { const bf16x8 p = *(const LAS bf16x8*)(QF + ro + 64 * ks);
                acc[tt][0] = __builtin_amdgcn_mfma_f32_16x16x32_bf16(Cf[0][ks], p, acc[tt][0], 0, 0, 0); acc[tt][1] = __builtin_amdgcn_mfma_f32_16x16x32_bf16(Cf[1][ks], p, acc[tt][1], 0, 0, 0); }
        }
#pragma unroll
        for (int tt = 0; tt < 8; ++tt) {
            const int ro = (16 * tt + fr) * PITCH + 16 * fq;
#pragma unroll
            for (int ks = 0; ks < 4; ++ks) { const bf16x8 p = *(const LAS bf16x8*)(QBk + ro + 64 * ks);
                acc[tt][0] = __builtin_amdgcn_mfma_f32_16x16x32_bf16(Cb[0][ks], p, acc[tt][0], 0, 0, 0); acc[tt][1] = __builtin_amdgcn_mfma_f32_16x16x32_bf16(Cb[1][ks], p, acc[tt][1], 0, 0, 0); }
            float ss = 0.f;
#pragma unroll
            for (int vt = 0; vt < 2; ++vt) ss += (acc[tt][vt].x * acc[tt][vt].x + acc[tt][vt].y * acc[tt][vt].y) + (acc[tt][vt].z * acc[tt][vt].z + acc[tt][vt].w * acc[tt][vt].w);
            ss += shx(ss, 16, lane); ss += shx(ss, 32, lane);
            if (fq == 0) RED[wave * 128 + 16 * tt + fr] = ss;
        }
        u32x2 sov[8][2];
        { size_t off = (T0 + fr) * 1024 + h * DV + 32 * wave + 4 * fq;
#pragma unroll
          for (int tt = 0; tt < 8; ++tt) { asm volatile("" : "+v"(off)); sov[tt][0] = *(const u32x2*)(SO + off); sov[tt][1] = *(const u32x2*)(SO + off + 16); off += 16 * 1024; } }
        __syncthreads();
        { const int col0 = h * DV + 32 * wave + 4 * fq;
          const f32x4 hn0 = *(const f32x4*)(head_norm + col0), hn1 = *(const f32x4*)(head_norm + col0 + 16);
          size_t off = (T0 + fr) * 1024 + col0;
#pragma unroll
          for (int tt = 0; tt < 8; ++tt) {
            asm volatile("" : "+v"(off));
            float tot = 0.f;
#pragma unroll
            for (int w = 0; w < 8; ++w) tot += RED[w * 128 + 16 * tt + fr];
            const float rstd = rsqrtf(tot * (1.f / DV) + EPS);
#pragma unroll
            for (int vt = 0; vt < 2; ++vt) {
                const f32x4 hn = vt ? hn1 : hn0; const u32x2 so = sov[tt][vt];
                const f32x4 a = acc[tt][vt]; u32x2 w;
                w.x = cvt_pk_bf16(a.x * rstd * hn.x * bf_lo(so.x), a.y * rstd * hn.y * bf_hi(so.x)); w.y = cvt_pk_bf16(a.z * rstd * hn.z * bf_lo(so.y), a.w * rstd * hn.w * bf_hi(so.y));
                *(u32x2*)(HM + off + 16 * vt) = w; }
            off += 16 * 1024;
          } }
        __syncthreads();
    }
}

__device__ __forceinline__ void gates_direct(const Frame& F, const float* bias) {
    const bf16_t* XB = (const bf16_t*)(F.ws + WS_XB); const bf16_t* WG = (const bf16_t*)(F.ws + WS_W) + WO_WIN + (size_t)1536 * DM;
    const float* SS = (const float*)(F.ws + WS_SS); float* GATES = (float*)(F.ws + WS_GATES);
    const int lane = F.lane, fr = lane & 15, fq = lane >> 4;
    for (int tile = F.bid * 8 + F.wave; tile < M / 16; tile += F.G * 8) {
        const bf16_t* ap = XB + (size_t)(tile * 16 + fr) * DM + 8 * fq; const bf16_t* bp = WG + (size_t)fr * DM + 8 * fq;
        f32x4 acc = {0.f, 0.f, 0.f, 0.f};
#pragma unroll 8
        for (int ks = 0; ks < 32; ++ks) { const bf16x8 a = *(const bf16x8*)(ap + 32 * ks), b = *(const bf16x8*)(bp + 32 * ks);
            acc = __builtin_amdgcn_mfma_f32_16x16x32_bf16(a, b, acc, 0, 0, 0); }
        const int row0 = tile * 16 + 4 * fq; const float bv = bias[fr];
        const f32x4 s4 = *(const f32x4*)(SS + row0);
        GATES[(size_t)(row0 + 0) * 16 + fr] = acc.x * rsqrtf(s4.x * (1.f / DM) + EPS) + bv; GATES[(size_t)(row0 + 1) * 16 + fr] = acc.y * rsqrtf(s4.y * (1.f / DM) + EPS) + bv;
        GATES[(size_t)(row0 + 2) * 16 + fr] = acc.z * rsqrtf(s4.z * (1.f / DM) + EPS) + bv; GATES[(size_t)(row0 + 3) * 16 + fr] = acc.w * rsqrtf(s4.w * (1.f / DM) + EPS) + bv;
    }
}

template <int HALF> struct PoolRows { u32x2 w[2 * HALF + 3]; };
template <int HALF>
__device__ __forceinline__ void pool_load(PoolRows<HALF>& R, const bf16_t* U, size_t row0, int bt0, int q) {
#pragma unroll
    for (int i = 0; i < 2 * HALF + 3; ++i) { int tt = bt0 - HALF + i; tt = tt < 0 ? 0 : (tt > SEQ - 1 ? SEQ - 1 : tt);
        R.w[i] = *((const u32x2*)(U + (row0 - bt0 + tt) * 1024) + q); }
}
template <int HALF>
__device__ __forceinline__ void pool_finish(const PoolRows<HALF>& R, bf16_t* Y0, size_t row0, int bt0, int q, int g) {
    constexpr int NR = 2 * HALF + 3;
    f32x4 r[NR];
#pragma unroll
    for (int i = 0; i < NR; ++i) { const int tt = bt0 - HALF + i; const float mk = (tt >= 0 && tt < SEQ) ? 1.f : 0.f;
        r[i] = (f32x4){bf_lo(R.w[i].x) * mk, bf_hi(R.w[i].x) * mk, bf_lo(R.w[i].y) * mk, bf_hi(R.w[i].y) * mk}; }
#pragma unroll
    for (int j = 0; j < 4; ++j) { const int t = bt0 + j; int lo = t - HALF; if (lo < 0) lo = 0; int hi = t + HALF; if (hi > SEQ) hi = SEQ;
        f32x4 sum = r[j];
#pragma unroll
        for (int i = 1; i < 2 * HALF; ++i) sum += r[j + i];
        const f32x4 y = sum * (1.0f / (float)(hi - lo)) - r[j + HALF];
        u32x2 w; w.x = cvt_pk_bf16(y.x, y.y); w.y = cvt_pk_bf16(y.z, y.w);
        *((u32x2*)(Y0 + ((size_t)g * M + row0 + j) * 256) + (q & 63)) = w; }
}
template <int HALF>
__device__ __forceinline__ void pool_run(const bf16_t* U1, bf16_t* Y0, int gt, int NGT, int q, int g) {
    PoolRows<HALF> cur, nxt;
    int it = gt; if (it >= (M / 4) * 256) return;
    { const size_t row0 = (size_t)(it >> 8) * 4; pool_load<HALF>(cur, U1, row0, (int)(row0 & (SEQ - 1)), q); }
    for (;;) {
        const int itn = it + NGT; const bool more = itn < (M / 4) * 256;
        if (more) { const size_t rown = (size_t)(itn >> 8) * 4; pool_load<HALF>(nxt, U1, rown, (int)(rown & (SEQ - 1)), q); }
        { const size_t row0 = (size_t)(it >> 8) * 4; pool_finish<HALF>(cur, Y0, row0, (int)(row0 & (SEQ - 1)), q, g); }
        if (!more) break;
        cur = nxt; it = itn;
    }
}
__device__ __forceinline__ void pool_phase(const Frame& F) {
    const bf16_t* U1 = (const bf16_t*)(F.ws + WS_U1); bf16_t* Y0 = (bf16_t*)(F.ws + WS_Y0);
    const int gt = F.bid * 512 + F.tid, NGT = F.G * 512;
    const int q = gt & 255, g = q >> 6;
    if (g == 0) pool_run<1>(U1, Y0, gt, NGT, q, g); else if (g == 1) pool_run<2>(U1, Y0, gt, NGT, q, g);
    else if (g == 2) pool_run<4>(U1, Y0, gt, NGT, q, g); else pool_run<8>(U1, Y0, gt, NGT, q, g);
}

__device__ __forceinline__ void final_phase(const Frame& F, const float* gain, const float* ss, const bf16_t* hb) {
    const int gw = F.bid * 8 + F.wave, NGW = F.G * 8;
    const f32x4* gr = (const f32x4*)gain + F.lane;
    for (int m0 = gw * 4; m0 < M; m0 += NGW * 4) {
        u32x2 w[4][4]; float r[4];
#pragma unroll
        for (int q = 0; q < 4; ++q) { const u32x2* hr = (const u32x2*)(hb + (size_t)(m0 + q) * DM) + F.lane; r[q] = rsqrtf(ss[m0 + q] * (1.f / DM) + EPS);
#pragma unroll
            for (int j = 0; j < 4; ++j) w[q][j] = hr[64 * j]; }
#pragma unroll
        for (int q = 0; q < 4; ++q) { f32x4* xr = (f32x4*)(F.out + (size_t)(m0 + q) * DM) + F.lane;
#pragma unroll
            for (int j = 0; j < 4; ++j) { const f32x4 v = {bf_lo(w[q][j].x), bf_hi(w[q][j].x), bf_lo(w[q][j].y), bf_hi(w[q][j].y)}; xr[64 * j] = v * r[q] * gr[64 * j]; } }
    }
}

#define XB_TMO      128
#define XB_XCNT(j)  (256  + 64 * (j))
#define XB_XSUB(j)  (1280 + 64 * (j))
#define XB_XGEN(j)  (2304 + 64 * (j))
#define XB_TOP      3328
#define XB_TOPGEN   3392
#define XCD_BAR_WORDS 3456
#define XB_SPIN_CAP (1u << 22)
__device__ __forceinline__ unsigned xb_ld(unsigned* p)              { return __hip_atomic_load(p, __ATOMIC_RELAXED, __HIP_MEMORY_SCOPE_AGENT); }
__device__ __forceinline__ unsigned xb_add(unsigned* p, unsigned v) { return __hip_atomic_fetch_add(p, v, __ATOMIC_RELAXED, __HIP_MEMORY_SCOPE_AGENT); }
__device__ __forceinline__ unsigned xb_xcc_id() { return (unsigned)__builtin_amdgcn_s_getreg((3 << 11) | 20) & 0xFu; }
#define XB_SPIN(cond, bar) do { unsigned _sp = 0; while (cond) { __builtin_amdgcn_s_sleep(1); \
    if ((++_sp & 255u) == 0u) { if (xb_ld(&(bar)[XB_TMO])) break; if (_sp > XB_SPIN_CAP) { atomicAdd(&(bar)[XB_TMO], 1u); break; } } } } while (0)
__device__ __forceinline__ void xcd_barrier_complete(unsigned* bar, unsigned x, unsigned& nloc, unsigned& nx) {
    const unsigned G = gridDim.x;
    unsigned sum, cnt, mine, sp = 0u;
    for (;;) {
        sum = 0u; cnt = 0u; mine = 0u;
#pragma unroll
        for (unsigned j = 0; j < 16; ++j) { const unsigned c = xb_ld(&bar[XB_XCNT(j)]); sum += c; cnt += (c > 0u) ? 1u : 0u; mine = (j == x) ? c : mine; }
        if (sum == G) break;
        __builtin_amdgcn_s_sleep(1);
        if ((++sp & 255u) == 0u) { if (xb_ld(&bar[XB_TMO])) break; if (sp > XB_SPIN_CAP) { atomicAdd(&bar[XB_TMO], 1u); break; } }
    }
    nloc = mine > 0u ? mine : 1u; nx = cnt > 0u ? cnt : 1u;
}
__device__ __forceinline__ void xcd_barrier(unsigned* bar, volatile LAS unsigned* st, int tid) {
    asm volatile("s_waitcnt vmcnt(0)" ::: "memory");
    __syncthreads();
    if (tid == 0) {
        __builtin_amdgcn_s_waitcnt(0);
        const unsigned x = xb_xcc_id();
        unsigned nloc = st[0], nx = st[1];
        if (nloc == 0u) { xcd_barrier_complete(bar, x, nloc, nx); st[0] = nloc; st[1] = nx; }
        const unsigned old = xb_add(&bar[XB_XSUB(x)], 1u);
        const unsigned gen = old / nloc;
        if (old + 1u == (gen + 1u) * nloc) {
            __builtin_amdgcn_fence(__ATOMIC_RELEASE, "agent");
            asm volatile("s_waitcnt vmcnt(0)" ::: "memory");
            const unsigned og = xb_add(&bar[XB_TOP], 1u);
            const unsigned tg = og / nx;
            if (og + 1u == (tg + 1u) * nx) xb_add(&bar[XB_TOPGEN], 1u);
            else XB_SPIN(xb_ld(&bar[XB_TOPGEN]) == tg, bar);
            __builtin_amdgcn_fence(__ATOMIC_ACQUIRE, "agent");
            xb_add(&bar[XB_XGEN(x)], 1u);
            asm volatile("s_waitcnt vmcnt(0)" ::: "memory");
        } else {
            XB_SPIN(xb_ld(&bar[XB_XGEN(x)]) == gen, bar);
            __builtin_amdgcn_fence(__ATOMIC_ACQUIRE, "agent");
            asm volatile("s_waitcnt vmcnt(0)" ::: "memory");
        }
    }
    __syncthreads();
}

constexpr int N_PHASES = 15;
typedef const __attribute__((address_space(4))) Args* KArgP;
__device__ __forceinline__ Args load_args_() {
    Args a{};
#if defined(__HIP_DEVICE_COMPILE__)
    KArgP p_ = (KArgP)__builtin_amdgcn_kernarg_segment_ptr(); asm volatile("" : "+s"(p_));
#pragma unroll
    for (int i = 0; i < 19; ++i) a.in[i] = p_->in[i];
    a.out = p_->out; a.ws = p_->ws; a.ph_lo = p_->ph_lo; a.ph_hi = p_->ph_hi;
#endif
    return a;
}
#define LOADARGS() load_args_()
#define MKFRAME(A) Frame F; F.lds = (LAS unsigned char*)lds_raw; { int l_ = lane_id_fresh(); F.lane = l_; int b_ = blockIdx.x; asm volatile("" : "+s"(b_)); F.bid = b_; } F.wave = wvid; F.tid = wvid * 64 + F.lane; F.G = gridDim.x; F.ws = (A).ws; F.out = (A).out; \
    unsigned char* ws = (A).ws; bf16_t* WB = (bf16_t*)(ws + WS_W); float* SS = (float*)(ws + WS_SS); bf16_t* XB = (bf16_t*)(ws + WS_XB); bf16_t* XB2 = (bf16_t*)(ws + WS_Y1); bf16_t* HMb = (bf16_t*)(ws + WS_HM); bf16_t* PB = (bf16_t*)(ws + WS_PB); bf16_t* ACT = (bf16_t*)(ws + WS_ACT); \
    (void)WB; (void)SS; (void)XB; (void)XB2; (void)HMb; (void)PB; (void)ACT;
__global__ void __launch_bounds__(512, 2) mk_fwd(Args args) {
    extern __shared__ __attribute__((aligned(16))) unsigned char lds_raw[];
    const int lo = args.ph_lo, hi = args.ph_hi;
#define LCTL ((volatile LAS unsigned*)((LAS unsigned char*)lds_raw + (LDS_BYTES - 64)))
    if (threadIdx.x == 0) { LCTL[0] = 0u; LCTL[1] = 0u; LCTL[2] = 0u; }
    __syncthreads();
    int wvid;
    { const int l0 = lane_id_fresh(); unsigned w = 0u;
      if (l0 == 0) w = __hip_atomic_fetch_add((LAS unsigned*)((LAS unsigned char*)lds_raw + (LDS_BYTES - 64)), 1u, __ATOMIC_RELAXED, __HIP_MEMORY_SCOPE_WORKGROUP);
      wvid = __builtin_amdgcn_readfirstlane((int)w);
      if (MK_MULTI == 0 && wvid == 0 && l0 == 0) (void)xb_add((unsigned*)args.ws + XB_XCNT(xb_xcc_id()), 1u); }
#ifndef PH_MASK
#define PH_MASK 0xFFFF
#endif
#define IN(k) ((((PH_MASK) >> (k)) & 1) && lo <= (k) && (k) < hi)
#define SEAM(k) do { if (lo <= (k) && (k) + 1 < hi) { if ((k) == 0) cg::this_grid().sync(); else { const Args A_ = LOADARGS(); int l_ = lane_id_fresh(); xcd_barrier((unsigned*)A_.ws, LCTL + 1, wvid * 64 + l_); } } } while (0)

    if (IN(0)) { const Args A = LOADARGS(); MKFRAME(A); p0_prologue(F, A); }
    SEAM(0);
    if (IN(1)) {
        const Args A = LOADARGS(); MKFRAME(A);
        gates_direct(F, A.in[7]);
        { pg8::Gemm g{XB, WB + WO_WIN, M, 1536, DM, 0}; pg8::StaticOrder S; S.init(M, 1536, F.G, F.bid);
          Epi<EP_QO> E; E.a = EpiArgs{}; E.a.ss_in = SS; E.a.qb = (bf16_t*)(ws + WS_QB); E.a.so = (bf16_t*)(ws + WS_SO); E.a.gates = (float*)(ws + WS_GATES); E.a.bias = A.in[7];
          pg8::gemm_phase(F.lds, g, S, E, wvid * 64 + lane_id_fresh()); }
        { pg8::Gemm g{XB, WB + WO_WIN + (size_t)NA * DM, M, NBK, DM, 0}; pg8::StaticOrder S; S.init(M, NBK, F.G, F.bid);
          Epi<EP_KV> E; E.a = EpiArgs{}; E.a.ss_in = SS; E.a.kb = (bf16_t*)(ws + WS_KB); E.a.kt = (bf16_t*)(ws + WS_KT); E.a.vt = (bf16_t*)(ws + WS_VT);
          pg8::gemm_phase(F.lds, g, S, E, wvid * 64 + lane_id_fresh()); }
    }
    SEAM(1);
    if (IN(2)) { const Args A = LOADARGS(); MKFRAME(A); mlstm_scan(F, A.out); }
    SEAM(2);
    if (IN(3)) { const Args A = LOADARGS(); MKFRAME(A); mlstm_out(F, A.in[8], A.out); }
    SEAM(3);
    if (IN(4)) {
        const Args A = LOADARGS(); MKFRAME(A);
        pg8::Gemm g{HMb, WB + WO_WOUT, M, DM, DM, 0}; pg8::StaticOrder S; S.init(M, DM, F.G, F.bid);
        Epi<EP_RES> E; E.a = EpiArgs{}; E.a.res16 = XB; E.a.xbo = XB; E.a.ss_out = SS + 1 * M;
        pg8::gemm_phase(F.lds, g, S, E, F.tid);
    }
    SEAM(4);
#pragma unroll
    for (int l = 0; l < 2; ++l) {
        const int pb = 5 + 7 * l;
        if (l == 1) {
            if (IN(8)) {
                const Args A = LOADARGS(); MKFRAME(A);
                pg8::Gemm g{XB2, WB + WO_PIN, M, DM, DM, 0}; pg8::StaticOrder S; S.init(M, DM, F.G, F.bid);
                Epi<EP_BF16S> E; E.a = EpiArgs{}; E.a.ss_in = SS + 3 * M; E.a.o16 = (bf16_t*)(ws + WS_U1); E.a.ldc = DM;
                pg8::gemm_phase(F.lds, g, S, E, F.tid);
            }
            SEAM(8);
            if (IN(9)) { const Args A = LOADARGS(); MKFRAME(A); pool_phase(F); }
            SEAM(9);
            if (IN(10)) {
                const Args A = LOADARGS(); MKFRAME(A);
                pg8::Gemm g{(const bf16_t*)(ws + WS_Y0), WB + WO_GRP, M, DM, 256, (size_t)M * 256}; pg8::StaticOrder S; S.init(M, DM, F.G, F.bid);
                Epi<EP_BF16> E; E.a = EpiArgs{}; E.a.o16 = HMb; E.a.ldc = DM;
                pg8::gemm_phase(F.lds, g, S, E, F.tid);
            }
            SEAM(10);
            if (IN(11)) {
                const Args A = LOADARGS(); MKFRAME(A);
                pg8::Gemm g{HMb, WB + WO_POUT, M, DM, DM, 0}; pg8::StaticOrder S; S.init(M, DM, F.G, F.bid);
                Epi<EP_RES> E; E.a = EpiArgs{}; E.a.res16 = XB2; E.a.xbo = XB; E.a.ss_out = SS + 4 * M;
                pg8::gemm_phase(F.lds, g, S, E, F.tid);
            }
            SEAM(11);
        }
        const int si = 1 + 3 * l;
        if (IN(pb)) {
            const Args A = LOADARGS(); MKFRAME(A);
            { pg8::Gemm g{XB, WB + WO_W1 + (size_t)l * FF * DM, M, FF, DM, 0}; pg8::StaticOrder S; S.init(M, FF, F.G, F.bid);
              Epi<EP_SQRELU> E; E.a = EpiArgs{}; E.a.ss_in = SS + si * M; E.a.o16 = ACT; E.a.ldc = FF;
              pg8::gemm_phase(F.lds, g, S, E, F.tid); }
            { pg8::Gemm g{PB + (size_t)l * M * PLE, WB + WO_PLE + (size_t)l * DM * PLE, M, DM, PLE, 0}; pg8::StaticOrder S; S.init(M, DM, F.G, F.bid);
              Epi<EP_BF16> E; E.a = EpiArgs{}; E.a.o16 = HMb; E.a.ldc = DM;
              pg8::gemm_phase(F.lds, g, S, E, wvid * 64 + lane_id_fresh()); }
        }
        SEAM(pb);
        if (IN(pb + 1)) {
            const Args A = LOADARGS(); MKFRAME(A);
            pg8::Gemm g{ACT, WB + WO_W2 + (size_t)l * FF * DM, M, DM, FF, 0}; pg8::StaticOrder S; S.init(M, DM, F.G, F.bid);
            Epi<EP_RES> E; E.a = EpiArgs{}; E.a.res16 = XB; E.a.xbo = XB; E.a.ss_out = SS + (si + 1) * M;
            pg8::gemm_phase(F.lds, g, S, E, F.tid);
        }
        SEAM(pb + 1);
        if (IN(pb + 2)) {
            const Args A = LOADARGS(); MKFRAME(A);
            pg8::Gemm g{XB, WB + WO_GATE + (size_t)l * DM * DM, M, DM, DM, 0}; pg8::StaticOrder S; S.init(M, DM, F.G, F.bid);
            Epi<EP_GATE> E; E.a = EpiArgs{}; E.a.ss_in = SS + (si + 1) * M; E.a.res16 = XB; E.a.xbo = XB2; E.a.ss_out = SS + (si + 2) * M;
            E.a.bias = A.in[18] + l * DM; E.a.pe = HMb;
            pg8::gemm_phase(F.lds, g, S, E, F.tid);
        }
        SEAM(pb + 2);
    }
    if (IN(15)) { const Args A = LOADARGS(); MKFRAME(A); final_phase(F, A.in[5], SS + 6 * M, XB2); }
#undef IN
#undef SEAM
}

extern "C" void kernel_launch(void* const* d_in, const int* in_sizes, int n_in, void* d_out, int out_size, void* d_ws, size_t ws_size, hipStream_t stream) {
    static int grid = 0;
    if (grid == 0) {
        if (n_in != 19 || out_size != M * DM || ws_size < WS_END) { fprintf(stderr, "kernel_launch: unexpected shapes (n_in %d out %d ws %zu)\n", n_in, out_size, ws_size); grid = -1; return; }
        int dev = 0, cus = 0, per_cu = 0;
        hipGetDevice(&dev); hipDeviceGetAttribute(&cus, hipDeviceAttributeMultiprocessorCount, dev);
        hipFuncSetAttribute((const void*)mk_fwd, hipFuncAttributeMaxDynamicSharedMemorySize, LDS_BYTES);
        if (hipOccupancyMaxActiveBlocksPerMultiprocessor(&per_cu, (const void*)mk_fwd, 512, LDS_BYTES) != hipSuccess || per_cu < 1) { fprintf(stderr, "kernel_launch: occupancy query gave %d\n", per_cu); per_cu = 1; }
        (void)hipGetLastError();
        grid = cus * per_cu;
        fprintf(stderr, "kernel_launch: grid %d (cus %d per_cu %d)\n", grid, cus, per_cu);
    }
    if (grid < 0) return;
    Args a{};
    for (int i = 0; i < 19; ++i) a.in[i] = (const float*)d_in[i];
    a.out = (float*)d_out; a.ws = (unsigned char*)d_ws;
    hipMemsetAsync(d_ws, 0, 16384, stream);
#if MK_MULTI
    for (int ph = 0; ph <= N_PHASES; ++ph) { a.ph_lo = ph; a.ph_hi = ph + 1; hipLaunchKernelGGL(mk_fwd, dim3(grid), dim3(512), LDS_BYTES, stream, a); }
#else
    a.ph_lo = 0; a.ph_hi = N_PHASES + 1;
    void* kargs[] = {&a};
    hipError_t e = hipLaunchCooperativeKernel((const void*)mk_fwd, dim3(grid), dim3(512), kargs, LDS_BYTES, stream);
    if (e != hipSuccess) fprintf(stderr, "cooperative launch failed: %s (grid %d)\n", hipGetErrorString(e), grid);
#ifdef PROBE_LIST
    { const int pl[] = {PROBE_LIST}; for (int ph : pl) { Args b = a; b.out = (float*)((unsigned char*)d_ws + WS_U1); b.ph_lo = ph; b.ph_hi = ph + 1; hipLaunchKernelGGL(mk_fwd, dim3(grid), dim3(512), LDS_BYTES, stream, b); } }
#endif
#endif
}
```
